# Optimizing an MI355X kernel written in HIP

```python
import math
import jax, jax.numpy as jnp
from jax import lax
import numpy as np

D_MODEL = 2048
BATCH = 4
SEQ = 2048
DEPTH = 1
DEC_BATCH = 128
DEC_SEQ = 4
PAST_LEN = 16384
PAGE_SIZE = 128

M_HEADS = 4
M_DV = D_MODEL // 2 // M_HEADS
M_DK = M_DV // 2
M_QK = M_HEADS * M_DK
M_V = M_HEADS * M_DV
M_CHUNK = 64
CONV_W = 4
A_HEADS = 16
A_KV_HEADS = 2
A_HD = D_MODEL // 2 // A_HEADS
A_Q = A_HEADS * A_HD
A_KV = A_KV_HEADS * A_HD
WINDOW = 128
ATT_BLOCK = WINDOW
N_BUCKETS = 32
MAX_DIST = 128
X_HEADS = 4
X_HD = 128
X_W = X_HEADS * X_HD
N_MEM = 256
D_FF = 4 * D_MODEL
EPS = 1e-6
NEG = -1e30
P_IN = 2 * M_QK + 2 * M_V + 2 * M_HEADS + A_Q + 2 * A_KV

kernel_name = 'hymba_mlstm_swa_sink_memxattn_step'


def rms_norm(x, g):
    xf = x.astype(jnp.float32)
    y = xf * lax.rsqrt(jnp.mean(xf * xf, axis=-1, keepdims=True) + EPS)
    return (y * g.astype(jnp.float32)).astype(x.dtype)


def causal_conv(x, buf, w, b):
    L = x.shape[1]
    xp = jnp.concatenate([buf.astype(x.dtype), x], axis=1)
    y = xp[:, 0:L] * w[0]
    for j in range(1, CONV_W):
        y = y + xp[:, j:j + L] * w[j]
    return jax.nn.silu(y + b), xp[:, xp.shape[1] - (CONV_W - 1):]


def t5_bucket(dist):
    n = jnp.maximum(dist, 0)
    max_exact = N_BUCKETS // 2
    nf = jnp.maximum(n, 1).astype(jnp.float32)
    large = max_exact + (jnp.log(nf / max_exact) / math.log(MAX_DIST / max_exact)
                         * (N_BUCKETS - max_exact)).astype(jnp.int32)
    large = jnp.minimum(large, N_BUCKETS - 1)
    return jnp.where(n < max_exact, n, large)


def mlstm_chunkwise(q, k, v, ig, fg, C0, n0, m0):
    B, L, H, DK = q.shape
    c = M_CHUNK if L % M_CHUNK == 0 else L
    nc = L // c
    k = k * (DK ** -0.5)
    lf = jax.nn.log_sigmoid(fg)

    def chunks(t):
        t = t.reshape((B, nc, c) + t.shape[2:])
        return jnp.swapaxes(jnp.moveaxis(t, 1, 0), 2, 3)

    causal = jnp.tril(jnp.ones((c, c), dtype=bool))

    def step(carry, inp):
        C, n, m = carry
        qc, kc, vc, ic, fc = inp
        b = jnp.cumsum(fc, axis=-1)
        D = jnp.where(causal, b[..., :, None] - b[..., None, :] + ic[..., None, :], -jnp.inf)
        inter = b + m[..., None]
        m_t = jnp.maximum(inter, jnp.max(D, axis=-1))
        w_intra = jnp.exp(D - m_t[..., None])
        w_inter = jnp.exp(inter - m_t)
        s = jnp.einsum('bhtd,bhsd->bhts', qc, kc) * w_intra
        num = (w_inter[..., None] * jnp.einsum('bhtd,bhde->bhte', qc, C)
               + jnp.einsum('bhts,bhse->bhte', s, vc))
        den = w_inter * jnp.einsum('bhtd,bhd->bht', qc, n) + jnp.sum(s, axis=-1)
        h = num / jnp.maximum(jnp.abs(den), jnp.exp(-m_t))[..., None]
        m_new = m_t[..., -1]
        decay = jnp.exp(b[..., -1] + m - m_new)
        w_state = jnp.exp(b[..., -1:] - b + ic - m_new[..., None])
        kw = kc * w_state[..., None]
        C_new = decay[..., None, None] * C + jnp.einsum('bhsd,bhse->bhde', kw, vc)
        n_new = decay[..., None] * n + jnp.sum(kw, axis=2)
        return (C_new, n_new, m_new), h

    (C, n, m), h = lax.scan(step, (C0, n0, m0),
                            (chunks(q), chunks(k), chunks(v), chunks(ig), chunks(lf)))
    h = jnp.moveaxis(jnp.swapaxes(h, 2, 3), 0, 1).reshape(B, L, H, v.shape[-1])
    return h, C, n, m


def banded_attention(q, k, v, dist, valid, sinks, rel_bias):
    B, N, Lq, H, D = q.shape
    KVH = k.shape[3]
    G = H // KVH
    Lk = k.shape[2]
    qg = q.reshape(B, N, Lq, KVH, G, D)
    s = jnp.einsum('bnqhgd,bnkhd->bnhgqk', qg, k.astype(q.dtype)).astype(jnp.float32) * (D ** -0.5)
    bias = rel_bias[t5_bucket(dist)].astype(jnp.float32)
    bias = bias.reshape(N, Lq, Lk, KVH, G).transpose(0, 3, 4, 1, 2)
    s = jnp.where(valid[None, :, None, None], s + bias[None], NEG)
    sink = jnp.broadcast_to(sinks.astype(jnp.float32).reshape(1, 1, KVH, G, 1, 1),
                            (B, N, KVH, G, Lq, 1))
    p = jax.nn.softmax(jnp.concatenate([s, sink], axis=-1), axis=-1)[..., :Lk]
    o = jnp.einsum('bnhgqk,bnkhd->bnqhgd', p.astype(v.dtype), v)
    return o.reshape(B, N, Lq, H * D)


def swa_prompt(q, k, v, sinks, rel_bias):
    B, L, H, D = q.shape
    nb = L // ATT_BLOCK

    def band(t):
        tp = jnp.pad(t, ((0, 0), (ATT_BLOCK, 0), (0, 0), (0, 0))).reshape(B, nb + 1, ATT_BLOCK, t.shape[2], D)
        return jnp.concatenate([tp[:, :-1], tp[:, 1:]], axis=2)

    a = jnp.arange(ATT_BLOCK)[:, None]
    j = jnp.arange(2 * ATT_BLOCK)[None, :]
    blk = jnp.arange(nb)[:, None, None]
    dist = jnp.broadcast_to(ATT_BLOCK + a - j, (nb, ATT_BLOCK, 2 * ATT_BLOCK))
    valid = (blk * ATT_BLOCK - ATT_BLOCK + j >= 0) & (dist >= 0) & (dist < WINDOW)
    o = banded_attention(q.reshape(B, nb, ATT_BLOCK, H, D), band(k), band(v), dist, valid, sinks, rel_bias)
    return o.reshape(B, L, H * D)


def swa_step(q, k, v, win_k, win_v, sinks, rel_bias):
    B, L, H, D = q.shape
    W = win_k.shape[1]
    kb = jnp.concatenate([win_k.astype(k.dtype), k], axis=1)
    vb = jnp.concatenate([win_v.astype(v.dtype), v], axis=1)
    dist = (W + jnp.arange(L)[:, None] - jnp.arange(W + L)[None, :])[None]
    valid = (dist >= 0) & (dist < WINDOW)
    o = banded_attention(q[:, None], kb[:, None], vb[:, None], dist, valid, sinks, rel_bias)
    return o.reshape(B, L, H * D), kb[:, L:], vb[:, L:]


def memory_kv(mem, norm_mem, wk, wv, k_norm):
    B = mem.shape[0]
    mn = rms_norm(mem, norm_mem)
    k = rms_norm((mn @ wk).reshape(B, N_MEM, X_HEADS, X_HD), k_norm)
    v = (mn @ wv).reshape(B, N_MEM, X_HEADS, X_HD)
    return k, v


def cross_attend(h, mem_k, mem_v, wq, q_norm, wo):
    B, L, _ = h.shape
    q = rms_norm((h @ wq).reshape(B, L, X_HEADS, X_HD), q_norm)
    s = jnp.einsum('blhd,bmhd->bhlm', q, mem_k.astype(q.dtype)).astype(jnp.float32) * (X_HD ** -0.5)
    p = jax.nn.softmax(s, axis=-1).astype(q.dtype)
    o = jnp.einsum('bhlm,bmhd->blhd', p, mem_v.astype(q.dtype)).reshape(B, L, X_W)
    return o @ wo


def trunk_layer(x, conv_buf, C0, n0, m0, win_k, win_v, mem_k, mem_v, rel_bias, p):
    B, L, _ = x.shape
    f32 = jnp.float32
    h = rms_norm(x, p['norm_mix'])
    proj = h @ p['w_in']
    sizes = [2 * M_QK, M_V, M_V, M_HEADS, M_HEADS, A_Q, A_KV, A_KV]
    idx = np.cumsum(sizes)[:-1].tolist()
    qk_m, v_m, o_m, ig, fg, q_a, k_a, v_a = jnp.split(proj, idx, axis=-1)
    qk_m, new_conv = causal_conv(qk_m, conv_buf, p['conv_w'], p['conv_b'])
    q_m, k_m = jnp.split(qk_m, 2, axis=-1)
    h_m, C, n, m = mlstm_chunkwise(
        q_m.reshape(B, L, M_HEADS, M_DK).astype(f32), k_m.reshape(B, L, M_HEADS, M_DK).astype(f32),
        v_m.reshape(B, L, M_HEADS, M_DV).astype(f32),
        (ig + p['b_igate']).astype(f32), (fg + p['b_fgate']).astype(f32),
        C0.astype(f32), n0.astype(f32), m0.astype(f32))
    h_m = rms_norm(h_m, p['m_out_norm'].reshape(M_HEADS, M_DV)).reshape(B, L, M_V).astype(x.dtype)
    h_m = h_m * jax.nn.sigmoid(o_m)
    q_a = rms_norm(q_a.reshape(B, L, A_HEADS, A_HD), p['q_norm_a'])
    k_a = rms_norm(k_a.reshape(B, L, A_KV_HEADS, A_HD), p['k_norm_a'])
    v_a = v_a.reshape(B, L, A_KV_HEADS, A_HD)
    if win_k is None:
        a_out = swa_prompt(q_a, k_a, v_a, p['sinks'], rel_bias)
        keep = max(L - WINDOW, 0)
        new_k, new_v = k_a[:, keep:], v_a[:, keep:]
    else:
        a_out, new_k, new_v = swa_step(q_a, k_a, v_a, win_k, win_v, p['sinks'], rel_bias)
    x = x + jnp.concatenate([h_m, a_out.astype(x.dtype)], axis=-1) @ p['w_out']
    x = x + cross_attend(rms_norm(x, p['norm_x']), mem_k, mem_v, p['wq_x'], p['q_norm_x'], p['wo_x'])
    u = rms_norm(x, p['norm_ffn']) @ p['w_up']
    x = x + jnp.square(jax.nn.relu(u)) @ p['w_down']
    dt = x.dtype
    return x, (new_conv, C.astype(dt), n.astype(dt), m.astype(dt), new_k, new_v)


def setup_inputs(seed: int = 0) -> dict:
    key = jax.random.key(seed)
    ks = list(jax.random.split(key, 40))
    cnt = [0]

    def nrm(shape, scale):
        k = ks[cnt[0]]
        cnt[0] += 1
        return scale * jax.random.normal(k, shape, jnp.float32)

    def gain(shape):
        return 1.0 + nrm(shape, 0.05)

    W_BUF = min(WINDOW, PAST_LEN)
    b_f = jnp.broadcast_to(jnp.linspace(3.0, 6.0, M_HEADS, dtype=jnp.float32), (DEPTH, M_HEADS))
    return {
        'x_prompt': nrm((BATCH, SEQ, D_MODEL), 1.0),
        'x_sample': nrm((DEC_BATCH, DEC_SEQ, D_MODEL), 1.0),
        'mem_prompt': nrm((BATCH, N_MEM, D_MODEL), 1.0),
        'state_conv': nrm((DEPTH, DEC_BATCH, CONV_W - 1, 2 * M_QK), 1.0),
        'state_C': nrm((DEPTH, DEC_BATCH, M_HEADS, M_DK, M_DV), 1.0),
        'state_n': nrm((DEPTH, DEC_BATCH, M_HEADS, M_DK), 1.0),
        'state_m': nrm((DEPTH, DEC_BATCH, M_HEADS), 1.0),
        'cache_swa_k': nrm((DEPTH, DEC_BATCH, W_BUF, A_KV_HEADS, A_HD), 1.0),
        'cache_swa_v': nrm((DEPTH, DEC_BATCH, W_BUF, A_KV_HEADS, A_HD), 1.0),
        'cache_mem_k': nrm((DEPTH, DEC_BATCH, N_MEM, X_HEADS, X_HD), 1.0),
        'cache_mem_v': nrm((DEPTH, DEC_BATCH, N_MEM, X_HEADS, X_HD), 1.0),
        'norm_mix': gain((DEPTH, D_MODEL)),
        'w_in': nrm((DEPTH, D_MODEL, P_IN), D_MODEL ** -0.5),
        'conv_w': nrm((DEPTH, CONV_W, 2 * M_QK), CONV_W ** -0.5),
        'conv_b': nrm((DEPTH, 2 * M_QK), 0.02),
        'b_igate': nrm((DEPTH, M_HEADS), 0.1),
        'b_fgate': b_f + nrm((DEPTH, M_HEADS), 0.1),
        'm_out_norm': gain((DEPTH, M_V)),
        'q_norm_a': gain((DEPTH, A_HD)),
        'k_norm_a': gain((DEPTH, A_HD)),
        'sinks': nrm((DEPTH, A_HEADS), 0.5),
        'w_out': nrm((DEPTH, M_V + A_Q, D_MODEL), (M_V + A_Q) ** -0.5),
        'rel_bias': nrm((N_BUCKETS, A_HEADS), 0.5),
        'norm_x': gain((DEPTH, D_MODEL)),
        'norm_mem': gain((DEPTH, D_MODEL)),
        'wq_x': nrm((DEPTH, D_MODEL, X_W), D_MODEL ** -0.5),
        'wk_x': nrm((DEPTH, D_MODEL, X_W), D_MODEL ** -0.5),
        'wv_x': nrm((DEPTH, D_MODEL, X_W), D_MODEL ** -0.5),
        'q_norm_x': gain((DEPTH, X_HD)),
        'k_norm_x': gain((DEPTH, X_HD)),
        'wo_x': nrm((DEPTH, X_W, D_MODEL), X_W ** -0.5),
        'norm_ffn': gain((DEPTH, D_MODEL)),
        'w_up': nrm((DEPTH, D_MODEL, D_FF), D_MODEL ** -0.5),
        'w_down': nrm((DEPTH, D_FF, D_MODEL), D_FF ** -0.5),
    }


def reference(x_prompt, x_sample, mem_prompt, state_conv, state_C, state_n, state_m,
              cache_swa_k, cache_swa_v, cache_mem_k, cache_mem_v,
              norm_mix, w_in, conv_w, conv_b, b_igate, b_fgate, m_out_norm, q_norm_a, k_norm_a,
              sinks, w_out, rel_bias, norm_x, norm_mem, wq_x, wk_x, wv_x, q_norm_x, k_norm_x,
              wo_x, norm_ffn, w_up, w_down):
    f32 = jnp.float32
    Bp = x_prompt.shape[0]
    yp, ys = x_prompt, x_sample
    pc, pC, pn, pm, pk, pv, pmk, pmv = [], [], [], [], [], [], [], []
    sc, sC, sn, sm, sk, sv = [], [], [], [], [], []
    for l in range(DEPTH):
        p = dict(norm_mix=norm_mix[l], w_in=w_in[l], conv_w=conv_w[l], conv_b=conv_b[l],
                 b_igate=b_igate[l], b_fgate=b_fgate[l], m_out_norm=m_out_norm[l],
                 q_norm_a=q_norm_a[l], k_norm_a=k_norm_a[l], sinks=sinks[l], w_out=w_out[l],
                 norm_x=norm_x[l], wq_x=wq_x[l], q_norm_x=q_norm_x[l], wo_x=wo_x[l],
                 norm_ffn=norm_ffn[l], w_up=w_up[l], w_down=w_down[l])
        mk, mv = memory_kv(mem_prompt, norm_mem[l], wk_x[l], wv_x[l], k_norm_x[l])
        yp, st_p = trunk_layer(
            yp, jnp.zeros((Bp, CONV_W - 1, 2 * M_QK), yp.dtype),
            jnp.zeros((Bp, M_HEADS, M_DK, M_DV), f32), jnp.zeros((Bp, M_HEADS, M_DK), f32),
            jnp.zeros((Bp, M_HEADS), f32), None, None, mk, mv, rel_bias, p)
        ys, st_s = trunk_layer(
            ys, state_conv[l], state_C[l], state_n[l], state_m[l], cache_swa_k[l], cache_swa_v[l],
            cache_mem_k[l], cache_mem_v[l], rel_bias, p)
        pc.append(st_p[0]); pC.append(st_p[1]); pn.append(st_p[2]); pm.append(st_p[3])
        pk.append(st_p[4]); pv.append(st_p[5]); pmk.append(mk); pmv.append(mv)
        sc.append(st_s[0]); sC.append(st_s[1]); sn.append(st_s[2]); sm.append(st_s[3])
        sk.append(st_s[4]); sv.append(st_s[5])
    p_conv = jnp.stack(pc); p_C = jnp.stack(pC); p_n = jnp.stack(pn); p_m = jnp.stack(pm)
    p_swa_k = jnp.stack(pk); p_swa_v = jnp.stack(pv)
    p_mem_k = jnp.stack(pmk); p_mem_v = jnp.stack(pmv)
    s_conv = jnp.stack(sc); s_C = jnp.stack(sC); s_n = jnp.stack(sn); s_m = jnp.stack(sm)
    s_swa_k = jnp.stack(sk); s_swa_v = jnp.stack(sv)
    return (yp, ys, p_conv, p_C, p_n, p_m, p_swa_k, p_swa_v, p_mem_k, p_mem_v,
            s_conv, s_C, s_n, s_m, s_swa_k, s_swa_v)
```

```cpp
#include <hip/hip_runtime.h>
#include <cstdio>
#include <cstdint>
namespace pg8 {
#define PG8_LAS __attribute__((address_space(3)))
typedef unsigned short bf16_t;
typedef short bf16x8 __attribute__((ext_vector_type(8)));
typedef float f32x4 __attribute__((ext_vector_type(4)));
typedef unsigned u32x4 __attribute__((ext_vector_type(4)));
constexpr int BM = 256, BK = 64, HALF = 128, HTB = HALF * BK * 2  , STAGE_BYTES = 8 * HTB, NXCD = 8, WGM = 8;

__host__ __device__ __forceinline__ int lds_byte(int r, int c) { const int st = (r >> 4) * 2 + (c >> 5), rr = r & 15, cc = c & 31, ob = rr * 64 + cc * 2; return st * 1024 + (ob ^ (((ob >> 9) & 1) << 5)); }
__host__ __device__ __forceinline__ void stage_rc(int b, int& R, int& C) { const int st = b / 1024, sb = b % 1024, swz = sb ^ (((sb >> 9) & 1) << 5); R = (st >> 1) * 16 + swz / 64; C = (st & 1) * 32 + (swz % 64) / 2; }
__host__ __device__ __forceinline__ int perm32(int rho) { const int n = rho >> 4, i = rho & 15; return 8 * (i >> 2) + 4 * n + (i & 3); }

struct Unit { int pm, pn; };
struct Gemm { const bf16_t* A; const bf16_t* Bt; int M, N, K; };

struct StaticOrder {
    int nM, nN, nwg, G, c;
    __host__ __device__ void init(int M, int N, int G_, int c_) { nM = M / BM; nN = N / BM; nwg = nM * nN; G = G_; c = c_; }
    __host__ __device__ bool next(int i, Unit& u) const {
        const long L = (long)i * G + c; if (L >= nwg) return false;
        int wgid = (int)L; { const int q = nwg / NXCD, r = nwg % NXCD, xcd = wgid % NXCD, off = wgid / NXCD; wgid = (xcd < r ? xcd * (q + 1) : r * (q + 1) + (xcd - r) * q) + off; }
        const int nig = WGM * nN, gid = wgid / nig, fm = gid * WGM, gsz = (nM - fm) < WGM ? (nM - fm) : WGM;
        u.pm = fm + ((wgid % nig) % gsz); u.pn = (wgid % nig) / gsz; return true;
    }
    __device__ __forceinline__ void a_ready(const Unit&) const {}
    __device__ __forceinline__ void done(const Unit&) const {}
};

__device__ __forceinline__ unsigned cvt_pk_bf16(float lo, float hi) { unsigned r; asm volatile("v_cvt_pk_bf16_f32 %0, %1, %2" : "=v"(r) : "v"(lo), "v"(hi)); return r; }
typedef float f32x2 __attribute__((ext_vector_type(2)));
template <class Epi, class Sched, bool ALIGN_EPI = false, bool SP2 = false>
__device__ __forceinline__ void gemm_phase(PG8_LAS unsigned char* lds, const Gemm g, const Sched& S, const Epi& E) {
    const int tid = threadIdx.x, wid = __builtin_amdgcn_readfirstlane(tid >> 6), lane = tid & 63, wr = wid >> 2, wc = wid & 3, fr = lane & 15, fq = lane >> 4;
    const int K = g.K, nt = K / BK;
    unsigned voffA[2], voffB[2];
#pragma unroll
    for (int i = 0; i < 2; ++i) { int R, C; stage_rc(tid * 16 + i * 8192, R, C); const int Rb = Epi::PERM ? ((R & ~31) + perm32(R & 31)) : R;
        voffA[i] = (unsigned)(R * K + C) * 2u; voffB[i] = (unsigned)(Rb * K + C) * 2u; }
    const size_t kstep = (size_t)(BK * 2);
    const size_t hstep = (size_t)HALF * K * 2;
    const size_t tstep = 2 * hstep;
    const unsigned ldsw = (unsigned)wid * 1024u;
    const int aoff = lds_byte(wr * 64 + fr, fq * 8), boff = lds_byte(wc * 32 + fr, fq * 8);
#define PG8_SA(b, h) (((b) * 2 + (h)) * HTB)
#define PG8_SB(b, h) ((4 + (b) * 2 + (h)) * HTB)
#define PG8_STAGE(bufoff, gbase, voff) do { _Pragma("unroll") for (int _i = 0; _i < 2; ++_i) \
        __builtin_amdgcn_global_load_lds((const unsigned*)((const char*)(gbase) + (voff)[_i]), (PG8_LAS unsigned*)(lds + (bufoff) + ldsw + _i * 8192), 16, 0, 0); } while (0)
#define PG8_LDA(dst, b, h) do { _Pragma("unroll") for (int m = 0; m < 4; ++m) _Pragma("unroll") for (int k = 0; k < 2; ++k) dst[m][k] = *(const PG8_LAS bf16x8*)(lds + PG8_SA(b, h) + aoff + m * 2048 + k * 1024); } while (0)
#define PG8_LDB(dst, b, h) do { _Pragma("unroll") for (int n = 0; n < 2; ++n) _Pragma("unroll") for (int k = 0; k < 2; ++k) dst[n][k] = *(const PG8_LAS bf16x8*)(lds + PG8_SB(b, h) + boff + n * 2048 + k * 1024); } while (0)
#define PG8_MMA(ai, bj, At, Bt) do { __builtin_amdgcn_s_setprio(1); _Pragma("unroll") for (int m = 0; m < 4; ++m) _Pragma("unroll") for (int n = 0; n < 2; ++n) _Pragma("unroll") for (int k = 0; k < 2; ++k) \
        acc[ai][bj][m][n] = __builtin_amdgcn_mfma_f32_16x16x32_bf16(Bt[n][k], At[m][k], acc[ai][bj][m][n], 0, 0, 0); __builtin_amdgcn_s_setprio(0); } while (0)
#define PG8_WAIT_V(n) asm volatile("s_waitcnt vmcnt(" #n ")" ::: "memory")
#define PG8_WAIT_L(n) asm volatile("s_waitcnt lgkmcnt(" #n ")" ::: "memory")
#define PG8_BAR __builtin_amdgcn_s_barrier()
#define PG8_SCHED __builtin_amdgcn_sched_barrier(0)
    Unit cur, nxt; int ui = 0;
    if (!S.next(0, cur)) return;
    f32x4 acc[2][2][4][2];
#pragma unroll
    for (int a = 0; a < 2; ++a)
#pragma unroll
        for (int b = 0; b < 2; ++b)
#pragma unroll
            for (int m = 0; m < 4; ++m)
#pragma unroll
                for (int n = 0; n < 2; ++n) acc[a][b][m][n] = (f32x4){0.f, 0.f, 0.f, 0.f};
    bf16x8 At[4][2], B0[2][2], B1[2][2];
    const char* cA = (const char*)g.A + (size_t)cur.pm * tstep; const char* cB = (const char*)g.Bt + (size_t)cur.pn * tstep;
    S.a_ready(cur);
    if constexpr (SP2) {
        PG8_STAGE(PG8_SB(0, 0), cB, voffB); PG8_STAGE(PG8_SB(0, 1), cB + hstep, voffB); PG8_STAGE(PG8_SA(0, 0), cA, voffA); PG8_STAGE(PG8_SA(0, 1), cA + hstep, voffA);
        if (wr == 1) PG8_BAR;
        PG8_WAIT_V(2); PG8_BAR;
        PG8_STAGE(PG8_SB(1, 0), cB + kstep, voffB); PG8_STAGE(PG8_SA(1, 0), cA + kstep, voffA); PG8_STAGE(PG8_SB(1, 1), cB + hstep + kstep, voffB);
        PG8_WAIT_V(6); PG8_BAR;
    } else {
        PG8_STAGE(PG8_SB(0, 0), cB, voffB); PG8_STAGE(PG8_SA(0, 0), cA, voffA); PG8_STAGE(PG8_SB(0, 1), cB + hstep, voffB); PG8_STAGE(PG8_SA(0, 1), cA + hstep, voffA);
        if (wr == 1) PG8_BAR;
        PG8_WAIT_V(4); PG8_BAR;
        PG8_STAGE(PG8_SB(1, 0), cB + kstep, voffB); PG8_STAGE(PG8_SA(1, 0), cA + kstep, voffA); PG8_STAGE(PG8_SB(1, 1), cB + hstep + kstep, voffB);
        PG8_WAIT_V(6); PG8_BAR;
    }
    for (;;) {
        const bool has_next = S.next(ui + 1, nxt);
        const char* nA = has_next ? (const char*)g.A + (size_t)nxt.pm * tstep : cA; const char* nB = has_next ? (const char*)g.Bt + (size_t)nxt.pn * tstep : cB;
        for (int t = 0; t < nt; t += 2) {
            const bool last = (t == nt - 2);
            const char* a1 = cA + (size_t)(t + 1) * kstep;
            const char* a2 = last ? nA : cA + (size_t)(t + 2) * kstep; const char* b2 = last ? nB : cB + (size_t)(t + 2) * kstep;
            const char* a3 = a2 + kstep; const char* b3 = b2 + kstep;
            if (last && has_next) S.a_ready(nxt);
            if constexpr (SP2) {
            PG8_LDB(B0, 0, 0); PG8_LDB(B1, 0, 1); PG8_SCHED; PG8_LDA(At, 0, 0); PG8_STAGE(PG8_SA(1, 1), a1 + hstep, voffA);
            PG8_WAIT_V(8); PG8_WAIT_L(0); PG8_BAR; PG8_MMA(0, 0, At, B0); PG8_MMA(0, 1, At, B1); PG8_BAR; PG8_SCHED;
            PG8_LDA(At, 0, 1); PG8_STAGE(PG8_SB(0, 0), b2, voffB); PG8_STAGE(PG8_SB(0, 1), b2 + hstep, voffB); PG8_STAGE(PG8_SA(0, 0), a2, voffA);
            PG8_WAIT_V(8); PG8_WAIT_L(0); PG8_BAR; PG8_MMA(1, 0, At, B0); PG8_MMA(1, 1, At, B1); PG8_BAR; PG8_SCHED;
            PG8_LDB(B0, 1, 0); PG8_LDB(B1, 1, 1); PG8_SCHED; PG8_LDA(At, 1, 0); PG8_STAGE(PG8_SA(0, 1), a2 + hstep, voffA);
            PG8_WAIT_V(8); PG8_WAIT_L(0); PG8_BAR; PG8_MMA(0, 0, At, B0); PG8_MMA(0, 1, At, B1); PG8_BAR; PG8_SCHED;
            PG8_LDA(At, 1, 1); PG8_STAGE(PG8_SB(1, 0), b3, voffB); PG8_STAGE(PG8_SB(1, 1), b3 + hstep, voffB); PG8_STAGE(PG8_SA(1, 0), a3, voffA);
            PG8_WAIT_V(8); PG8_WAIT_L(0); PG8_BAR; PG8_MMA(1, 0, At, B0); PG8_MMA(1, 1, At, B1); PG8_BAR; PG8_SCHED;
            } else {
            PG8_LDB(B0, 0, 0); PG8_SCHED; PG8_LDA(At, 0, 0); PG8_STAGE(PG8_SA(1, 1), a1 + hstep, voffA);
            PG8_WAIT_L(8); PG8_BAR; PG8_WAIT_L(0); PG8_MMA(0, 0, At, B0); PG8_BAR; PG8_SCHED;
            PG8_LDB(B1, 0, 1); PG8_STAGE(PG8_SB(0, 0), b2, voffB);
            PG8_BAR; PG8_WAIT_L(0); PG8_MMA(0, 1, At, B1); PG8_BAR;
            PG8_LDA(At, 0, 1); PG8_STAGE(PG8_SA(0, 0), a2, voffA);
            PG8_BAR; PG8_WAIT_L(0); PG8_MMA(1, 0, At, B0); PG8_BAR; PG8_SCHED;
            PG8_STAGE(PG8_SB(0, 1), b2 + hstep, voffB);
            PG8_WAIT_V(6); PG8_BAR; PG8_MMA(1, 1, At, B1); PG8_BAR;
            PG8_LDB(B0, 1, 0); PG8_SCHED; PG8_LDA(At, 1, 0); PG8_STAGE(PG8_SA(0, 1), a2 + hstep, voffA);
            PG8_WAIT_L(8); PG8_BAR; PG8_WAIT_L(0); PG8_MMA(0, 0, At, B0); PG8_BAR; PG8_SCHED;
            PG8_LDB(B1, 1, 1); PG8_STAGE(PG8_SB(1, 0), b3, voffB);
            PG8_BAR; PG8_WAIT_L(0); PG8_MMA(0, 1, At, B1); PG8_BAR;
            PG8_LDA(At, 1, 1); PG8_STAGE(PG8_SA(1, 0), a3, voffA);
            PG8_BAR; PG8_WAIT_L(0); PG8_MMA(1, 0, At, B0); PG8_BAR; PG8_SCHED;
            PG8_STAGE(PG8_SB(1, 1), b3 + hstep, voffB);
            PG8_WAIT_V(6); PG8_BAR; PG8_MMA(1, 1, At, B1); PG8_BAR;
            }
        }
        if constexpr (ALIGN_EPI) { if (wr == 0) PG8_BAR; }
        if constexpr (!Epi::AFTER_DRAIN) { E(acc, cur, wr, wc, fr, fq); S.done(cur); }
        if (!has_next) break;
#pragma unroll
        for (int a = 0; a < 2; ++a)
#pragma unroll
            for (int b = 0; b < 2; ++b)
#pragma unroll
                for (int m = 0; m < 4; ++m)
#pragma unroll
                    for (int n = 0; n < 2; ++n) acc[a][b][m][n] = (f32x4){0.f, 0.f, 0.f, 0.f};
        cur = nxt; cA = nA; cB = nB; ++ui;
        if constexpr (ALIGN_EPI) { if (wr == 1) PG8_BAR; }
    }
    PG8_WAIT_V(0);
    if constexpr (!ALIGN_EPI) { if (wr == 0) PG8_BAR; }
    PG8_BAR;
    if constexpr (Epi::AFTER_DRAIN) { E.fused(acc, cur, wr, wc, fr, fq, lds, wid, lane); S.done(cur); }
#undef PG8_SA
#undef PG8_SB
#undef PG8_STAGE
#undef PG8_LDA
#undef PG8_LDB
#undef PG8_MMA
#undef PG8_WAIT_V
#undef PG8_WAIT_L
#undef PG8_BAR
#undef PG8_SCHED
}
}
namespace pg8 {
typedef unsigned u32x2 __attribute__((ext_vector_type(2)));
struct EpiBf16Plain {
    static constexpr bool PERM = true, AFTER_DRAIN = false;
    bf16_t* O; int ldc;
    __device__ __forceinline__ void operator()(const f32x4 (&acc)[2][2][4][2], const Unit& u, int wr, int wc, int fr, int fq) const {
        const int row0 = u.pm * BM + wr * 64 + fr, col0 = u.pn * BM + wc * 32 + 8 * fq;
#pragma unroll
        for (int ai = 0; ai < 2; ++ai)
#pragma unroll
            for (int m = 0; m < 4; ++m) { bf16_t* rowp = O + (size_t)(row0 + ai * HALF + m * 16) * ldc + col0;
#pragma unroll
                for (int bj = 0; bj < 2; ++bj) { const f32x4 v0 = acc[ai][bj][m][0], v1 = acc[ai][bj][m][1];
                    u32x4 w; w.x = cvt_pk_bf16(v0[0], v0[1]); w.y = cvt_pk_bf16(v0[2], v0[3]); w.z = cvt_pk_bf16(v1[0], v1[1]); w.w = cvt_pk_bf16(v1[2], v1[3]);
                    *(u32x4*)(rowp + bj * HALF) = w; } }
    }
};
struct EpiF32Plain {
    static constexpr bool PERM = false, AFTER_DRAIN = false;
    float* C; int ldc;
    __device__ __forceinline__ void operator()(const f32x4 (&acc)[2][2][4][2], const Unit& u, int wr, int wc, int fr, int fq) const {
        const int row0 = u.pm * BM + wr * 64 + fr, col0 = u.pn * BM + wc * 32 + 4 * fq;
#pragma unroll
        for (int ai = 0; ai < 2; ++ai)
#pragma unroll
            for (int m = 0; m < 4; ++m) { float* rowp = C + (size_t)(row0 + ai * HALF + m * 16) * ldc + col0;
#pragma unroll
                for (int bj = 0; bj < 2; ++bj)
#pragma unroll
                    for (int n = 0; n < 2; ++n) *(f32x4*)(rowp + bj * HALF + n * 16) = acc[ai][bj][m][n]; }
    }
};
template <bool WITH_XB> struct EpiResid {
    static constexpr bool PERM = false, AFTER_DRAIN = false;
    const float* r0; const float* r1; int split_row; float* out; bf16_t* xb; float* rowss; int ldc;
    __device__ __forceinline__ void operator()(const f32x4 (&acc)[2][2][4][2], const Unit& u, int wr, int wc, int fr, int fq) const {
        const int row0 = u.pm * BM + wr * 64 + fr, col0 = u.pn * BM + wc * 32 + 4 * fq;
#pragma unroll
        for (int ai = 0; ai < 2; ++ai)
#pragma unroll
            for (int m = 0; m < 4; ++m) { const int row = row0 + ai * HALF + m * 16;
                const float* rp = (row < split_row ? r0 + (size_t)row * ldc : r1 + (size_t)(row - split_row) * ldc) + col0;
                float* op = out + (size_t)row * ldc + col0; float ss = 0.f;
#pragma unroll
                for (int bj = 0; bj < 2; ++bj)
#pragma unroll
                    for (int n = 0; n < 2; ++n) { const f32x4 o = *(const f32x4*)(rp + bj * HALF + n * 16) + acc[ai][bj][m][n];
                        *(f32x4*)(op + bj * HALF + n * 16) = o;
                        if (WITH_XB) { ss += (o[0] * o[0] + o[1] * o[1]) + (o[2] * o[2] + o[3] * o[3]);
                            u32x2 w; w.x = cvt_pk_bf16(o[0], o[1]); w.y = cvt_pk_bf16(o[2], o[3]);
                            *(u32x2*)(xb + (size_t)row * ldc + col0 + bj * HALF + n * 16) = w; } }
                if (WITH_XB) { ss += __shfl_xor(ss, 16); ss += __shfl_xor(ss, 32); if (fq == 0) atomicAdd(rowss + row, ss); } }
    }
};
template <int ACT> struct EpiScaleBf16 {
    static constexpr bool PERM = true, AFTER_DRAIN = false;
    bf16_t* O; int ldc; const float* rowss; float inv_k, eps;
    __device__ __forceinline__ void operator()(const f32x4 (&acc)[2][2][4][2], const Unit& u, int wr, int wc, int fr, int fq) const {
        const int row0 = u.pm * BM + wr * 64 + fr, col0 = u.pn * BM + wc * 32 + 8 * fq;
#pragma unroll
        for (int ai = 0; ai < 2; ++ai)
#pragma unroll
            for (int m = 0; m < 4; ++m) { const int row = row0 + ai * HALF + m * 16; bf16_t* rowp = O + (size_t)row * ldc + col0;
                const float rs = 1.0f / sqrtf(rowss[row] * inv_k + eps);
#pragma unroll
                for (int bj = 0; bj < 2; ++bj) { f32x4 v0 = acc[ai][bj][m][0] * rs, v1 = acc[ai][bj][m][1] * rs;
                    if (ACT == 1) {
#pragma unroll
                        for (int e = 0; e < 4; ++e) { const float a = fmaxf(v0[e], 0.f), b = fmaxf(v1[e], 0.f); v0[e] = a * a; v1[e] = b * b; } }
                    u32x4 w; w.x = cvt_pk_bf16(v0[0], v0[1]); w.y = cvt_pk_bf16(v0[2], v0[3]); w.z = cvt_pk_bf16(v1[0], v1[1]); w.w = cvt_pk_bf16(v1[2], v1[3]);
                    *(u32x4*)(rowp + bj * HALF) = w; } }
    }
};
}
#define GAS __attribute__((address_space(1)))
#define LAS __attribute__((address_space(3)))
typedef unsigned short bf16;
typedef unsigned v4u __attribute__((ext_vector_type(4)));
typedef float f32x4 __attribute__((ext_vector_type(4)));
typedef short bf16x8 __attribute__((ext_vector_type(8)));
typedef GAS unsigned gu32;
typedef GAS unsigned long long gu64;
#define RLX_AGENT __ATOMIC_RELAXED, __HIP_MEMORY_SCOPE_AGENT
#define LDS_WAIT() asm volatile("s_waitcnt lgkmcnt(0)" ::: "memory")
#define VM_WAIT() asm volatile("s_waitcnt vmcnt(0)" ::: "memory")
__device__ __forceinline__ unsigned long long rt() { return __builtin_amdgcn_s_memrealtime(); }
__device__ __forceinline__ unsigned f2bf(float f) { unsigned u = __builtin_bit_cast(unsigned, f); return (u + 0x7fffu + ((u >> 16) & 1u)) >> 16; }
__device__ __forceinline__ unsigned pk2(float lo, float hi) { return f2bf(lo) | (f2bf(hi) << 16); }
#define XB_TMO      128
#define XB_XCNT(j)  (256  + 64 * (j))
#define XB_XSUB(j)  (1280 + 64 * (j))
#define XB_XGEN(j)  (2304 + 64 * (j))
#define XB_TOP      3328
#define XB_TOPGEN   3392
#define XCD_BAR_WORDS 3456
#define XB_SPIN_CAP (1u << 18)

__device__ __forceinline__ unsigned xb_ld(unsigned* p)              { return __hip_atomic_load(p, __ATOMIC_RELAXED, __HIP_MEMORY_SCOPE_AGENT); }
__device__ __forceinline__ unsigned xb_add(unsigned* p, unsigned v) { return __hip_atomic_fetch_add(p, v, __ATOMIC_RELAXED, __HIP_MEMORY_SCOPE_AGENT); }
__device__ __forceinline__ unsigned xb_xcc_id() { return (unsigned)__builtin_amdgcn_s_getreg((3 << 11) | 20) & 0xFu; }
#define XB_SPIN(cond, bar) do { unsigned _sp = 0; while (cond) { __builtin_amdgcn_s_sleep(1); \
    if ((++_sp & 255u) == 0u) { if (xb_ld(&(bar)[XB_TMO])) break; if (_sp > XB_SPIN_CAP) { atomicAdd(&(bar)[XB_TMO], 1u); break; } } } } while (0)

struct XcdBarrier {
    unsigned* bar; unsigned x;
    volatile LAS unsigned* st;
};

__device__ __forceinline__ XcdBarrier xcd_barrier_post(unsigned* bar, volatile LAS unsigned* st) {
    XcdBarrier b; b.bar = bar; b.x = xb_xcc_id(); b.st = st;
    if (threadIdx.x == 0) (void)xb_add(&bar[XB_XCNT(b.x)], 1u);
    return b;
}
__device__ __forceinline__ void xcd_barrier_complete(unsigned* bar, unsigned x, unsigned& nloc, unsigned& nx) {
    const unsigned G = gridDim.x * gridDim.y * gridDim.z;
    unsigned sum, cnt, mine, sp = 0u;
    for (;;) {
        sum = 0u; cnt = 0u; mine = 0u;
#pragma unroll
        for (unsigned j = 0; j < 16; ++j) { const unsigned c = xb_ld(&bar[XB_XCNT(j)]); sum += c; cnt += (c > 0u) ? 1u : 0u; mine = (j == x) ? c : mine; }
        if (sum == G) break;
        __builtin_amdgcn_s_sleep(1);
        if ((++sp & 255u) == 0u) { if (xb_ld(&bar[XB_TMO])) break; if (sp > XB_SPIN_CAP) { atomicAdd(&bar[XB_TMO], 1u); break; } }
    }
    nloc = mine > 0u ? mine : 1u; nx = cnt > 0u ? cnt : 1u;
}

__device__ __forceinline__ void xcd_barrier(const XcdBarrier& b) {
    asm volatile("s_waitcnt vmcnt(0)" ::: "memory");
    __syncthreads();
    if (threadIdx.x == 0) {
        unsigned* bar = b.bar;
        __builtin_amdgcn_s_waitcnt(0);
        unsigned nloc = b.st[0], nx = b.st[1];
        if (nloc == 0u) { xcd_barrier_complete(bar, b.x, nloc, nx); b.st[0] = nloc; b.st[1] = nx; }
        const unsigned old = xb_add(&bar[XB_XSUB(b.x)], 1u);
        const unsigned gen = old / nloc;
        if (old + 1u == (gen + 1u) * nloc) {
            __builtin_amdgcn_fence(__ATOMIC_RELEASE, "agent");
            asm volatile("s_waitcnt vmcnt(0)" ::: "memory");
            const unsigned og = xb_add(&bar[XB_TOP], 1u);
            const unsigned tg = og / nx;
            if (og + 1u == (tg + 1u) * nx) xb_add(&bar[XB_TOPGEN], 1u);
            else XB_SPIN(xb_ld(&bar[XB_TOPGEN]) == tg, bar);
            __builtin_amdgcn_fence(__ATOMIC_ACQUIRE, "agent");
            xb_add(&bar[XB_XGEN(b.x)], 1u);
            asm volatile("s_waitcnt vmcnt(0)" ::: "memory");
        } else {
            XB_SPIN(xb_ld(&bar[XB_XGEN(b.x)]) == gen, bar);
            __builtin_amdgcn_fence(__ATOMIC_ACQUIRE, "agent");
            asm volatile("s_waitcnt vmcnt(0)" ::: "memory");
        }
    }
    __syncthreads();
}
constexpr int NWAVES = 8, NTHR = NWAVES * 64;
constexpr int DM = 2048, BATCH = 4, SEQ = 2048, DECB = 128, DECS = 4;
constexpr int TP = BATCH * SEQ, TS = DECB * DECS, TT = TP + TS;
constexpr int MH = 4, MDK = 128, MDV = 256, MQK = 512, MV = 1024;
constexpr int AH = 16, AKV = 2, AHD = 64, WIN = 128;
constexpr int XH = 4, XHD = 128, XW = 512, NMEM = 256;
constexpr int DFF = 8192, PIN = 4360, NPROJ = 4352;
constexpr int C_QK = 0, C_VM = 1024, C_OM = 2048, C_QA = 3072, C_KA = 4096, C_VA = 4224;
constexpr float EPS = 1e-6f;
constexpr float LOG2E = 1.4426950408889634f;
constexpr size_t O_YP = 0, O_YS = O_YP + (size_t)TP * DM, O_PCONV = O_YS + (size_t)TS * DM, O_PC = O_PCONV + 4 * 3 * 1024, O_PN = O_PC + 4 * 4 * 128 * 256,
    O_PM = O_PN + 4 * 4 * 128, O_PSK = O_PM + 16, O_PSV = O_PSK + 4 * 128 * 128, O_PMK = O_PSV + 4 * 128 * 128, O_PMV = O_PMK + 4 * 256 * 512,
    O_SCONV = O_PMV + 4 * 256 * 512, O_SC = O_SCONV + 128 * 3 * 1024, O_SN = O_SC + (size_t)128 * 4 * 128 * 256, O_SM = O_SN + 128 * 4 * 128,
    O_SSK = O_SM + 512, O_SSV = O_SSK + (size_t)128 * 128 * 128, O_END = O_SSV + (size_t)128 * 128 * 128;
constexpr size_t MiB = 1u << 20;
constexpr size_t WS_CTL = 0, CTL_ZERO_BYTES = 2 * MiB;
constexpr size_t WS_RSS1 = 1 * MiB, WS_RSS2 = 1 * MiB + 64 * 1024;
constexpr size_t WS_GATES = 2 * MiB;
constexpr size_t WS_GB = 3 * MiB, WS_GM = 3 * MiB + 128 * 1024;
constexpr size_t WS_MKV = 4 * MiB;
constexpr size_t WS_WIN = 8 * MiB, WS_WOUT = 25 * MiB, WS_WQ = 33 * MiB, WS_WKV = 35 * MiB, WS_WO = 39 * MiB, WS_WUP = 41 * MiB, WS_WDN = 73 * MiB;
constexpr size_t WS_H = 105 * MiB;
constexpr size_t WS_MN = 139 * MiB;
constexpr size_t WS_QX = 143 * MiB, WS_OX = 152 * MiB;
constexpr size_t WS_PROJ = 161 * MiB, WS_QKM = 234 * MiB, WS_MIX = 251 * MiB;
constexpr size_t WS_U2 = 161 * MiB;
constexpr size_t WS_END = 297 * MiB;
static_assert(WS_WIN + (size_t)NPROJ * DM * 2 <= WS_WOUT && WS_PROJ + (size_t)TT * NPROJ * 2 <= WS_QKM && WS_QKM + (size_t)TT * 1024 * 2 <= WS_MIX && WS_MIX + (size_t)TT * DM * 2 <= WS_END && WS_U2 + (size_t)TT * DFF * 2 <= WS_END, "ws map");
static_assert(WS_H + (size_t)TT * DM * 2 <= WS_MN && WS_QX + (size_t)TT * XW * 2 <= WS_OX && WS_OX + (size_t)TT * XW * 2 <= WS_PROJ, "ws map 2");
constexpr int CW_BAR = 4096;
constexpr int RING_BYTES = 131072, LDSCTL_OFF = RING_BYTES, MISC_OFF = LDSCTL_OFF + 320, LDS_BYTES = 147456;

struct Args { const float* in[34]; float* out; unsigned char* ws; int ph_lo, ph_hi; };

struct Frame {
    LAS unsigned char* lds; volatile LAS unsigned* MISC; gu32* ctl;
    int tid, lane, wave, vcu, G, gw, ngw;
};
__device__ __forceinline__ float wave_sum(float v) {
#pragma unroll
    for (int o = 1; o < 64; o <<= 1) v += __shfl_xor(v, o);
    return v;
}
__device__ __forceinline__ float wave_max(float v) {
#pragma unroll
    for (int o = 1; o < 64; o <<= 1) v = fmaxf(v, __shfl_xor(v, o));
    return v;
}
__device__ __forceinline__ float bf2f(unsigned short b) { return __builtin_bit_cast(float, (unsigned)b << 16); }
__device__ __forceinline__ float bflo(unsigned w) { return __builtin_bit_cast(float, w << 16); }
__device__ __forceinline__ float bfhi(unsigned w) { return __builtin_bit_cast(float, w & 0xffff0000u); }
__device__ __forceinline__ float logsigmoidf(float x) { return fminf(x, 0.f) - log1pf(expf(-fabsf(x))); }
__device__ __forceinline__ float sigmoidf_(float x) { return 1.0f / (1.0f + expf(-x)); }

__device__ __forceinline__ void p0_transpose_item(const float* W, int K, int ldw, int nsrc0, bf16* WT, int ndst0, const float* gain, LAS float* scr, int k0, int lane) {
#pragma unroll 8
    for (int i = 0; i < 32; ++i) { const int kk = 2 * i + (lane >> 5); float v = W[(size_t)(k0 + kk) * ldw + nsrc0 + (lane & 31)]; if (gain) v *= gain[k0 + kk]; scr[kk * 33 + (lane & 31)] = v; }
    LDS_WAIT(); asm volatile("" ::: "memory");
    const int c = lane & 7;
#pragma unroll
    for (int j = 0; j < 4; ++j) { const int n = (lane >> 3) + 8 * j; const LAS float* s = scr + (8 * c) * 33 + n;
        v4u o; o.x = pk2(s[0 * 33], s[1 * 33]); o.y = pk2(s[2 * 33], s[3 * 33]); o.z = pk2(s[4 * 33], s[5 * 33]); o.w = pk2(s[6 * 33], s[7 * 33]);
        *(GAS v4u*)(WT + (size_t)(ndst0 + n) * K + k0 + 8 * c) = o; }
    LDS_WAIT(); asm volatile("" ::: "memory");
}
__device__ __forceinline__ void p0_prologue(Frame& F, const Args& A) {
    unsigned char* ws = A.ws;
    LAS float* scr = (LAS float*)(F.lds + F.wave * 16384);
    constexpr int I_IN = 32 * (NPROJ / 32), I_OUT = 32 * 64, I_Q = 32 * 16, I_O = 8 * 64, I_UP = 32 * 256, I_DN = 128 * 64;
    constexpr int NITEMS = I_IN + I_OUT + 3 * I_Q + I_O + I_UP + I_DN;
    for (int it = F.gw; it < NITEMS; it += F.ngw) {
        int r = it;
        if (r < I_IN) { const int nb = r % (NPROJ / 32), kb = r / (NPROJ / 32), nd = nb * 32, ns = nd < 3072 ? nd : nd + 8;
            p0_transpose_item(A.in[12], DM, PIN, ns, (bf16*)(ws + WS_WIN), nd, nullptr, scr, kb * 64, F.lane); continue; } r -= I_IN;
        if (r < I_OUT) { const int nb = r % 64, kb = r / 64; p0_transpose_item(A.in[21], DM, DM, nb * 32, (bf16*)(ws + WS_WOUT), nb * 32, nullptr, scr, kb * 64, F.lane); continue; } r -= I_OUT;
        if (r < I_Q) { const int nb = r % 16, kb = r / 16; p0_transpose_item(A.in[25], DM, XW, nb * 32, (bf16*)(ws + WS_WQ), nb * 32, A.in[23], scr, kb * 64, F.lane); continue; } r -= I_Q;
        if (r < I_Q) { const int nb = r % 16, kb = r / 16; p0_transpose_item(A.in[26], DM, XW, nb * 32, (bf16*)(ws + WS_WKV), nb * 32, nullptr, scr, kb * 64, F.lane); continue; } r -= I_Q;
        if (r < I_Q) { const int nb = r % 16, kb = r / 16; p0_transpose_item(A.in[27], DM, XW, nb * 32, (bf16*)(ws + WS_WKV), 512 + nb * 32, nullptr, scr, kb * 64, F.lane); continue; } r -= I_Q;
        if (r < I_O) { const int nb = r % 64, kb = r / 64; p0_transpose_item(A.in[30], XW, DM, nb * 32, (bf16*)(ws + WS_WO), nb * 32, nullptr, scr, kb * 64, F.lane); continue; } r -= I_O;
        if (r < I_UP) { const int nb = r % 256, kb = r / 256; p0_transpose_item(A.in[32], DM, DFF, nb * 32, (bf16*)(ws + WS_WUP), nb * 32, A.in[31], scr, kb * 64, F.lane); continue; } r -= I_UP;
        { const int nb = r % 64, kb = r / 64; p0_transpose_item(A.in[33], DFF, DM, nb * 32, (bf16*)(ws + WS_WDN), nb * 32, nullptr, scr, kb * 64, F.lane); }
    }
    __syncthreads();
    LAS float* gwl = (LAS float*)F.lds;
    for (int e = F.tid; e < DM * 8; e += NTHR) { const int k = e >> 3, j = e & 7; gwl[e] = A.in[12][(size_t)k * PIN + 3072 + j] * A.in[11][k]; }
    __syncthreads();
    for (int m = F.gw; m < TT + BATCH * NMEM; m += F.ngw) {
        const bool ismem = m >= TT;
        const float* xrow = m < TP ? A.in[0] + (size_t)m * DM : (m < TT ? A.in[1] + (size_t)(m - TP) * DM : A.in[2] + (size_t)(m - TT) * DM);
        const float* g = ismem ? A.in[24] : A.in[11];
        bf16* orow = ismem ? (bf16*)(ws + WS_MN) + (size_t)(m - TT) * DM : (bf16*)(ws + WS_H) + (size_t)m * DM;
        const GAS f32x4* xr = (const GAS f32x4*)xrow + F.lane;
        f32x4 v[8]; float s = 0.f;
#pragma unroll
        for (int j = 0; j < 8; ++j) { v[j] = xr[64 * j]; s += (v[j].x * v[j].x + v[j].y * v[j].y) + (v[j].z * v[j].z + v[j].w * v[j].w); }
        const float rs = 1.0f / sqrtf(wave_sum(s) * (1.f / DM) + EPS);
        GAS unsigned long long* o8 = (GAS unsigned long long*)orow + F.lane;
#pragma unroll
        for (int j = 0; j < 8; ++j) { const f32x4 gg = *((const GAS f32x4*)g + F.lane + 64 * j);
            o8[64 * j] = (unsigned long long)pk2(v[j].x * rs * gg.x, v[j].y * rs * gg.y) | ((unsigned long long)pk2(v[j].z * rs * gg.z, v[j].w * rs * gg.w) << 32); }
        if (!ismem) {
            float d[8];
#pragma unroll
            for (int q = 0; q < 8; ++q) d[q] = 0.f;
#pragma unroll
            for (int j = 0; j < 8; ++j)
#pragma unroll
                for (int e = 0; e < 4; ++e) { const int k = 256 * j + 4 * F.lane + e; const f32x4 w0 = *(const LAS f32x4*)(gwl + k * 8), w1 = *(const LAS f32x4*)(gwl + k * 8 + 4); const float xv = v[j][e];
                    d[0] += xv * w0.x; d[1] += xv * w0.y; d[2] += xv * w0.z; d[3] += xv * w0.w; d[4] += xv * w1.x; d[5] += xv * w1.y; d[6] += xv * w1.z; d[7] += xv * w1.w; }
#pragma unroll
            for (int q = 0; q < 8; ++q) d[q] = wave_sum(d[q]) * rs;
            if (F.lane == 0) { float* go = (float*)(ws + WS_GATES) + (size_t)m * 8;
#pragma unroll
                for (int q = 0; q < 8; ++q) go[q] = d[q]; }
        }
    }
    __syncthreads();
}
__device__ __forceinline__ void unpack8(const v4u w, float (&x)[8]) { x[0] = bflo(w.x); x[1] = bfhi(w.x); x[2] = bflo(w.y); x[3] = bfhi(w.y); x[4] = bflo(w.z); x[5] = bfhi(w.z); x[6] = bflo(w.w); x[7] = bfhi(w.w); }
__device__ __forceinline__ void p2_prep(Frame& F, const Args& A) {
    unsigned char* ws = A.ws; float* out = A.out;
    bf16* PROJ = (bf16*)(ws + WS_PROJ); bf16* QKM = (bf16*)(ws + WS_QKM);
    const float* GATES = (const float*)(ws + WS_GATES);
    const float* convw = A.in[13]; const float* convb = A.in[14];
    const int lane = F.lane;
    for (int r = F.gw; r < TT; r += F.ngw) {
        const bool pr = r < TP; int b, t;
        if (pr) { b = r / SEQ; t = r % SEQ; } else { b = (r - TP) / DECS; t = (r - TP) % DECS; }
#pragma unroll
        for (int half = 0; half < 2; ++half) {
            const int c0 = half * 512 + 8 * lane;
            float acc[8], cur[8];
#pragma unroll
            for (int e = 0; e < 8; ++e) { acc[e] = convb[c0 + e]; cur[e] = 0.f; }
#pragma unroll
            for (int j = 0; j < 4; ++j) {
                const int tt = t - 3 + j; float xv[8];
                if (tt >= 0) { const v4u raw = *(const GAS v4u*)(PROJ + (size_t)(r - 3 + j) * NPROJ + c0); unpack8(raw, xv); }
                else if (pr) {
#pragma unroll
                    for (int e = 0; e < 8; ++e) xv[e] = 0.f; }
                else { const float* sp = A.in[3] + ((size_t)b * 3 + (3 + tt)) * 1024 + c0; const f32x4 a0 = *(const GAS f32x4*)sp, a1 = *(const GAS f32x4*)(sp + 4);
                    xv[0] = a0.x; xv[1] = a0.y; xv[2] = a0.z; xv[3] = a0.w; xv[4] = a1.x; xv[5] = a1.y; xv[6] = a1.z; xv[7] = a1.w; }
                const f32x4 w0 = *(const GAS f32x4*)(convw + j * 1024 + c0), w1 = *(const GAS f32x4*)(convw + j * 1024 + c0 + 4);
                acc[0] += w0.x * xv[0]; acc[1] += w0.y * xv[1]; acc[2] += w0.z * xv[2]; acc[3] += w0.w * xv[3];
                acc[4] += w1.x * xv[4]; acc[5] += w1.y * xv[5]; acc[6] += w1.z * xv[6]; acc[7] += w1.w * xv[7];
                if (j == 3) {
#pragma unroll
                    for (int e = 0; e < 8; ++e) cur[e] = xv[e]; }
            }
            const float sc = half ? 0.08838834764831845f : 1.0f;
#pragma unroll
            for (int e = 0; e < 8; ++e) acc[e] = acc[e] / (1.0f + expf(-acc[e])) * sc;
            v4u o; o.x = pk2(acc[0], acc[1]); o.y = pk2(acc[2], acc[3]); o.z = pk2(acc[4], acc[5]); o.w = pk2(acc[6], acc[7]);
            *(GAS v4u*)(QKM + (size_t)r * 1024 + c0) = o;
            float* cdst = nullptr;
            if (pr && t >= SEQ - 3) cdst = out + O_PCONV + ((size_t)b * 3 + (t - (SEQ - 3))) * 1024 + c0;
            if (!pr && t >= 1) cdst = out + O_SCONV + ((size_t)b * 3 + (t - 1)) * 1024 + c0;
            if (cdst) { *(GAS f32x4*)cdst = (f32x4){cur[0], cur[1], cur[2], cur[3]}; *(GAS f32x4*)(cdst + 4) = (f32x4){cur[4], cur[5], cur[6], cur[7]}; }
        }
        {
            bf16* qp = PROJ + (size_t)r * NPROJ + C_QA + 16 * lane; float x[16];
            { float a[8], c[8]; unpack8(*(const GAS v4u*)qp, a); unpack8(*(const GAS v4u*)(qp + 8), c);
#pragma unroll
              for (int e = 0; e < 8; ++e) { x[e] = a[e]; x[8 + e] = c[e]; } }
            float ss = 0.f;
#pragma unroll
            for (int e = 0; e < 16; ++e) ss += x[e] * x[e];
            ss += __shfl_xor(ss, 1); ss += __shfl_xor(ss, 2);
            const float rs = 0.125f / sqrtf(ss * (1.f / 64.f) + EPS); const float* g = A.in[18] + 16 * (lane & 3);
#pragma unroll
            for (int e = 0; e < 16; ++e) x[e] = x[e] * rs * g[e];
            v4u o0, o1; o0.x = pk2(x[0], x[1]); o0.y = pk2(x[2], x[3]); o0.z = pk2(x[4], x[5]); o0.w = pk2(x[6], x[7]);
            o1.x = pk2(x[8], x[9]); o1.y = pk2(x[10], x[11]); o1.z = pk2(x[12], x[13]); o1.w = pk2(x[14], x[15]);
            *(GAS v4u*)qp = o0; *(GAS v4u*)(qp + 8) = o1;
        }
        {
            unsigned* kp = (unsigned*)(PROJ + (size_t)r * NPROJ + C_KA + 2 * lane); const unsigned kw = *kp;
            float k0 = bflo(kw), k1 = bfhi(kw); float ss = k0 * k0 + k1 * k1;
#pragma unroll
            for (int o = 1; o < 32; o <<= 1) ss += __shfl_xor(ss, o);
            const float rs = 1.0f / sqrtf(ss * (1.f / 64.f) + EPS); const float* g = A.in[19] + 2 * (lane & 31);
            k0 = k0 * rs * g[0]; k1 = k1 * rs * g[1];
            *kp = pk2(k0, k1);
            const unsigned vw = *(const unsigned*)(PROJ + (size_t)r * NPROJ + C_VA + 2 * lane); const float v0 = bflo(vw), v1 = bfhi(vw);
            if (pr && t >= SEQ - WIN) { const size_t o = ((size_t)b * WIN + (t - (SEQ - WIN))) * 128 + 2 * lane;
                out[O_PSK + o] = k0; out[O_PSK + o + 1] = k1; out[O_PSV + o] = v0; out[O_PSV + o + 1] = v1; }
            if (!pr) { const size_t o = ((size_t)b * WIN + (WIN - DECS + t)) * 128 + 2 * lane;
                out[O_SSK + o] = k0; out[O_SSK + o + 1] = k1; out[O_SSV + o] = v0; out[O_SSV + o + 1] = v1; }
        }
    }
    { const int n4 = DECB * (WIN - DECS) * 32; const int gt = F.gw * 64 + lane, ngt = F.ngw * 64;
      for (int e = gt; e < 2 * n4; e += ngt) { const int which = e >= n4, i = which ? e - n4 : e; const int b = i / ((WIN - DECS) * 32), rem = i % ((WIN - DECS) * 32);
          const f32x4 v = *((const GAS f32x4*)(A.in[which ? 8 : 7] + ((size_t)b * WIN + DECS) * 128) + rem);
          *((GAS f32x4*)(out + (which ? O_SSV : O_SSK) + (size_t)b * WIN * 128) + rem) = v; } }
    for (int r = F.gw; r < BATCH * NMEM; r += F.ngw) {
        const float* src = (const float*)(ws + WS_MKV) + (size_t)r * 1024;
        const f32x4 a0 = *(const GAS f32x4*)(src + 8 * lane), a1 = *(const GAS f32x4*)(src + 8 * lane + 4);
        float ss = (a0.x * a0.x + a0.y * a0.y) + (a0.z * a0.z + a0.w * a0.w) + (a1.x * a1.x + a1.y * a1.y) + (a1.z * a1.z + a1.w * a1.w);
#pragma unroll
        for (int o = 1; o < 16; o <<= 1) ss += __shfl_xor(ss, o);
        const float rs = 1.0f / sqrtf(ss * (1.f / 128.f) + EPS); const float* g = A.in[29] + 8 * (lane & 15);
        const f32x4 g0 = *(const GAS f32x4*)g, g1 = *(const GAS f32x4*)(g + 4);
        float* ko = out + O_PMK + (size_t)r * 512 + 8 * lane;
        *(GAS f32x4*)ko = a0 * rs * g0; *(GAS f32x4*)(ko + 4) = a1 * rs * g1;
        float* vo = out + O_PMV + (size_t)r * 512 + 8 * lane;
        *(GAS f32x4*)vo = *(const GAS f32x4*)(src + 512 + 8 * lane); *(GAS f32x4*)(vo + 4) = *(const GAS f32x4*)(src + 512 + 8 * lane + 4);
    }
    for (int bh = F.gw; bh < BATCH * MH; bh += F.ngw) {
        const int b = bh >> 2, h = bh & 3; const float bi = A.in[15][h], bfg = A.in[16][h];
        const float* gp = GATES + ((size_t)b * SEQ + 32 * lane) * 8;
        float a = 0.f, bv = -INFINITY;
        for (int s = 0; s < 32; ++s) { const float lf = logsigmoidf(gp[s * 8 + 4 + h] + bfg), ig = gp[s * 8 + h] + bi; a += lf; bv = fmaxf(bv + lf, ig); }
        float pa = a, pb = bv;
#pragma unroll
        for (int o = 1; o < 64; o <<= 1) { const float a1 = __shfl_up(pa, o), b1 = __shfl_up(pb, o); if (lane >= o) { pb = fmaxf(b1 + pa, pb); pa = a1 + pa; } }
        float ea = __shfl_up(pa, 1), eb = __shfl_up(pb, 1); if (lane == 0) { ea = 0.f; eb = -INFINITY; }
        float bc = ea, m = fmaxf(0.f + ea, eb);
        float* gbo = (float*)(ws + WS_GB) + (size_t)bh * SEQ + 32 * lane; float* gmo = (float*)(ws + WS_GM) + (size_t)bh * SEQ + 32 * lane;
        for (int s = 0; s < 32; ++s) { const float lf = logsigmoidf(gp[s * 8 + 4 + h] + bfg), ig = gp[s * 8 + h] + bi; bc += lf; m = fmaxf(m + lf, ig); gbo[s] = bc; gmo[s] = m; }
        if (lane == 63) out[O_PM + bh] = m;
    }
}
#define WAVE_LDS_SYNC() do { asm volatile("s_waitcnt lgkmcnt(0)" ::: "memory"); __builtin_amdgcn_wave_barrier(); } while (0)
__device__ __forceinline__ int t5_bucket(int n) {
    if (n < 16) return n;
    int l = 16 + (int)(logf((float)n * (1.f / 16.f)) / 2.0794415416798357f * 16.f);
    return l < 31 ? l : 31;
}
__device__ __forceinline__ void naive_mlstm_prompt(Frame& F, const Args& A) {
    unsigned char* ws = A.ws; const int lane = F.lane;
    const bf16* PROJ = (const bf16*)(ws + WS_PROJ); const bf16* QKM = (const bf16*)(ws + WS_QKM); bf16* MIX = (bf16*)(ws + WS_MIX);
    const float* GATES = (const float*)(ws + WS_GATES); const float* GB = (const float*)(ws + WS_GB); const float* GM = (const float*)(ws + WS_GM);
    LAS float* Pw = (LAS float*)(F.lds + F.wave * 16384); LAS float* qw = Pw + 2048;
    for (int idx = F.gw; idx < BATCH * MH * SEQ; idx += F.ngw) {
        const int bh = idx / SEQ, tt = idx % SEQ, t = (bh & 1) ? SEQ - 1 - tt : tt, b = bh >> 2, h = bh & 3;
        const size_t row = (size_t)b * SEQ + t; const float bi = A.in[15][h];
        const float at = GB[bh * SEQ + t] - GM[bh * SEQ + t], em = expf(-GM[bh * SEQ + t]);
        WAVE_LDS_SYNC();
        qw[lane] = bf2f(QKM[row * 1024 + h * 128 + lane]); qw[lane + 64] = bf2f(QKM[row * 1024 + h * 128 + lane + 64]);
        WAVE_LDS_SYNC();
        float den = 0.f;
        for (int s = lane; s <= t; s += 64) {
            const size_t rs_ = (size_t)b * SEQ + s; const bf16* kr = QKM + rs_ * 1024 + 512 + h * 128; float dot = 0.f;
#pragma unroll 4
            for (int c = 0; c < 16; ++c) { float kx[8]; unpack8(*(const GAS v4u*)(kr + 8 * c), kx); const f32x4 q0 = *(const LAS f32x4*)(qw + 8 * c), q1 = *(const LAS f32x4*)(qw + 8 * c + 4);
                dot += (kx[0] * q0.x + kx[1] * q0.y) + (kx[2] * q0.z + kx[3] * q0.w) + (kx[4] * q1.x + kx[5] * q1.y) + (kx[6] * q1.z + kx[7] * q1.w); }
            const float cs = GATES[rs_ * 8 + h] + bi - GB[bh * SEQ + s];
            const float p = dot * expf(at + cs); Pw[s] = p; den += p;
        }
        den = wave_sum(den);
        WAVE_LDS_SYNC();
        float a0 = 0.f, a1 = 0.f, a2 = 0.f, a3 = 0.f;
        const bf16* vb = PROJ + (size_t)b * SEQ * NPROJ + C_VM + h * 256 + 4 * lane;
#pragma unroll 4
        for (int s = 0; s <= t; ++s) { const float p = Pw[s]; const unsigned long long vv = *(const GAS unsigned long long*)(vb + (size_t)s * NPROJ); const unsigned lo = (unsigned)vv, hi = (unsigned)(vv >> 32);
            a0 += p * bflo(lo); a1 += p * bfhi(lo); a2 += p * bflo(hi); a3 += p * bfhi(hi); }
        const float dn = 1.0f / fmaxf(fabsf(den), em);
        a0 *= dn; a1 *= dn; a2 *= dn; a3 *= dn;
        const float ss = wave_sum((a0 * a0 + a1 * a1) + (a2 * a2 + a3 * a3)); const float rn = 1.0f / sqrtf(ss * (1.f / 256.f) + EPS);
        const f32x4 g = *(const GAS f32x4*)(A.in[17] + h * 256 + 4 * lane);
        const unsigned long long ov = *(const GAS unsigned long long*)(PROJ + row * NPROJ + C_OM + h * 256 + 4 * lane); const unsigned olo = (unsigned)ov, ohi = (unsigned)(ov >> 32);
        a0 = a0 * rn * g.x * sigmoidf_(bflo(olo)); a1 = a1 * rn * g.y * sigmoidf_(bfhi(olo)); a2 = a2 * rn * g.z * sigmoidf_(bflo(ohi)); a3 = a3 * rn * g.w * sigmoidf_(bfhi(ohi));
        *(GAS unsigned long long*)(MIX + row * DM + h * 256 + 4 * lane) = (unsigned long long)pk2(a0, a1) | ((unsigned long long)pk2(a2, a3) << 32);
    }
}
__device__ __forceinline__ void naive_mlstm_prompt_state(Frame& F, const Args& A) {
    unsigned char* ws = A.ws; const int lane = F.lane; float* out = A.out;
    const bf16* PROJ = (const bf16*)(ws + WS_PROJ); const bf16* QKM = (const bf16*)(ws + WS_QKM);
    const float* GATES = (const float*)(ws + WS_GATES); const float* GB = (const float*)(ws + WS_GB); const float* GM = (const float*)(ws + WS_GM);
    for (int idx = F.gw; idx < BATCH * MH * MDK; idx += F.ngw) {
        const int bh = idx / MDK, dk = idx % MDK, b = bh >> 2, h = bh & 3; const float bi = A.in[15][h];
        const float base = GB[bh * SEQ + SEQ - 1] - GM[bh * SEQ + SEQ - 1];
        float a0 = 0.f, a1 = 0.f, a2 = 0.f, a3 = 0.f, na = 0.f;
        const bf16* vb = PROJ + (size_t)b * SEQ * NPROJ + C_VM + h * 256 + 4 * lane;
#pragma unroll 4
        for (int s = 0; s < SEQ; ++s) { const size_t rs_ = (size_t)b * SEQ + s;
            const float w = expf(base - GB[bh * SEQ + s] + GATES[rs_ * 8 + h] + bi) * bf2f(QKM[rs_ * 1024 + 512 + h * 128 + dk]);
            const unsigned long long vv = *(const GAS unsigned long long*)(vb + (size_t)s * NPROJ); const unsigned lo = (unsigned)vv, hi = (unsigned)(vv >> 32);
            a0 += w * bflo(lo); a1 += w * bfhi(lo); a2 += w * bflo(hi); a3 += w * bfhi(hi); na += w; }
        *(GAS f32x4*)(out + O_PC + ((size_t)bh * MDK + dk) * MDV + 4 * lane) = (f32x4){a0, a1, a2, a3};
        if (lane == 0) out[O_PN + bh * MDK + dk] = na;
    }
}
__device__ __forceinline__ void naive_mlstm_sample(Frame& F, const Args& A) {
    unsigned char* ws = A.ws; const int lane = F.lane; float* out = A.out;
    const bf16* PROJ = (const bf16*)(ws + WS_PROJ); const bf16* QKM = (const bf16*)(ws + WS_QKM); bf16* MIX = (bf16*)(ws + WS_MIX);
    const float* GATES = (const float*)(ws + WS_GATES);
    LAS float* qs = (LAS float*)(F.lds + F.wave * 16384); LAS float* ks = qs + 512;
    for (int idx = F.gw; idx < DECB * MH; idx += F.ngw) {
        const int b = idx >> 2, h = idx & 3; const size_t r0 = (size_t)TP + 4 * b;
        const float bi = A.in[15][h], bfg = A.in[16][h], m0 = A.in[6][idx];
        float ig[4], bc[4], mt[4]; { float c = 0.f;
#pragma unroll
            for (int i = 0; i < 4; ++i) { ig[i] = GATES[(r0 + i) * 8 + h] + bi; c += logsigmoidf(GATES[(r0 + i) * 8 + 4 + h] + bfg); bc[i] = c; } }
#pragma unroll
        for (int i = 0; i < 4; ++i) { float m = bc[i] + m0;
#pragma unroll
            for (int s = 0; s <= i; ++s) m = fmaxf(m, bc[i] - bc[s] + ig[s]);
            mt[i] = m; }
        WAVE_LDS_SYNC();
#pragma unroll
        for (int i = 0; i < 4; ++i) { qs[i * 128 + lane] = bf2f(QKM[(r0 + i) * 1024 + h * 128 + lane]); qs[i * 128 + lane + 64] = bf2f(QKM[(r0 + i) * 1024 + h * 128 + lane + 64]);
            ks[i * 128 + lane] = bf2f(QKM[(r0 + i) * 1024 + 512 + h * 128 + lane]); ks[i * 128 + lane + 64] = bf2f(QKM[(r0 + i) * 1024 + 512 + h * 128 + lane + 64]); }
        WAVE_LDS_SYNC();
        const float* n0p = A.in[5] + (size_t)idx * MDK; const float n0a = n0p[lane], n0b = n0p[lane + 64];
        float S[4][4], qn[4];
#pragma unroll
        for (int i = 0; i < 4; ++i) { qn[i] = wave_sum(qs[i * 128 + lane] * n0a + qs[i * 128 + lane + 64] * n0b);
#pragma unroll
            for (int s = 0; s < 4; ++s) { S[i][s] = 0.f; if (s <= i) S[i][s] = wave_sum(qs[i * 128 + lane] * ks[s * 128 + lane] + qs[i * 128 + lane + 64] * ks[s * 128 + lane + 64]) * expf(bc[i] - bc[s] + ig[s] - mt[i]); } }
        const float mnew = mt[3], decay = expf(bc[3] + m0 - mnew); float wst[4];
#pragma unroll
        for (int s = 0; s < 4; ++s) wst[s] = expf(bc[3] - bc[s] + ig[s] - mnew);
        f32x4 v[4], qc[4];
#pragma unroll
        for (int i = 0; i < 4; ++i) { const unsigned long long vv = *(const GAS unsigned long long*)(PROJ + (r0 + i) * NPROJ + C_VM + h * 256 + 4 * lane); const unsigned lo = (unsigned)vv, hi = (unsigned)(vv >> 32);
            v[i] = (f32x4){bflo(lo), bfhi(lo), bflo(hi), bfhi(hi)}; qc[i] = (f32x4){0.f, 0.f, 0.f, 0.f}; }
        const float* c0p = A.in[4] + (size_t)idx * MDK * MDV + 4 * lane; float* cnp = out + O_SC + (size_t)idx * MDK * MDV + 4 * lane;
#pragma unroll 4
        for (int dk = 0; dk < MDK; ++dk) { const f32x4 c0 = *(const GAS f32x4*)(c0p + (size_t)dk * MDV);
            f32x4 cn = c0 * decay;
#pragma unroll
            for (int i = 0; i < 4; ++i) { qc[i] += c0 * qs[i * 128 + dk]; cn += v[i] * (ks[i * 128 + dk] * wst[i]); }
            *(GAS f32x4*)(cnp + (size_t)dk * MDV) = cn; }
        { float na = decay * n0a, nb = decay * n0b;
#pragma unroll
          for (int s = 0; s < 4; ++s) { na += ks[s * 128 + lane] * wst[s]; nb += ks[s * 128 + lane + 64] * wst[s]; }
          out[O_SN + (size_t)idx * MDK + lane] = na; out[O_SN + (size_t)idx * MDK + lane + 64] = nb; if (lane == 0) out[O_SM + idx] = mnew; }
        const f32x4 g = *(const GAS f32x4*)(A.in[17] + h * 256 + 4 * lane);
#pragma unroll
        for (int i = 0; i < 4; ++i) { const float wi = expf(bc[i] + m0 - mt[i]); f32x4 num = qc[i] * wi; float den = wi * qn[i];
#pragma unroll
            for (int s = 0; s < 4; ++s) { num += v[s] * S[i][s]; den += S[i][s]; }
            num = num * (1.0f / fmaxf(fabsf(den), expf(-mt[i])));
            const float ss = wave_sum((num.x * num.x + num.y * num.y) + (num.z * num.z + num.w * num.w)); const float rn = 1.0f / sqrtf(ss * (1.f / 256.f) + EPS);
            const unsigned long long ov = *(const GAS unsigned long long*)(PROJ + (r0 + i) * NPROJ + C_OM + h * 256 + 4 * lane); const unsigned olo = (unsigned)ov, ohi = (unsigned)(ov >> 32);
            const float o0 = num.x * rn * g.x * sigmoidf_(bflo(olo)), o1 = num.y * rn * g.y * sigmoidf_(bfhi(olo)), o2 = num.z * rn * g.z * sigmoidf_(bflo(ohi)), o3 = num.w * rn * g.w * sigmoidf_(bfhi(ohi));
            *(GAS unsigned long long*)(MIX + (r0 + i) * DM + h * 256 + 4 * lane) = (unsigned long long)pk2(o0, o1) | ((unsigned long long)pk2(o2, o3) << 32); }
    }
}
__device__ __forceinline__ void naive_swa(Frame& F, const Args& A) {
    unsigned char* ws = A.ws; const int lane = F.lane;
    const bf16* PROJ = (const bf16*)(ws + WS_PROJ); bf16* MIX = (bf16*)(ws + WS_MIX);
    LAS float* Pw = (LAS float*)(F.lds + F.wave * 16384); LAS float* qw = Pw + 256;
    for (int idx = F.gw; idx < TT * AH; idx += F.ngw) {
        const int head = idx & 15, r = idx >> 4, kvh = head >> 3; const bool pr = r < TP;
        int b, t; if (pr) { b = r / SEQ; t = r % SEQ; } else { b = (r - TP) / DECS; t = (r - TP) % DECS; }
        WAVE_LDS_SYNC();
        qw[lane] = bf2f(PROJ[(size_t)r * NPROJ + C_QA + head * 64 + lane]);
        WAVE_LDS_SYNC();
        const float sink = A.in[20][head];
        float sc[2]; bool vl[2];
#pragma unroll
        for (int jj = 0; jj < 2; ++jj) {
            const int j = lane + 64 * jj, dist = 127 - j;
            float dot = 0.f; bool valid;
            if (pr) { const int pos = t - dist; valid = pos >= 0;
                if (valid) { const bf16* kr = PROJ + ((size_t)b * SEQ + pos) * NPROJ + C_KA + kvh * 64;
#pragma unroll
                    for (int c = 0; c < 8; ++c) { float kx[8]; unpack8(*(const GAS v4u*)(kr + 8 * c), kx); const f32x4 q0 = *(const LAS f32x4*)(qw + 8 * c), q1 = *(const LAS f32x4*)(qw + 8 * c + 4);
                        dot += (kx[0] * q0.x + kx[1] * q0.y) + (kx[2] * q0.z + kx[3] * q0.w) + (kx[4] * q1.x + kx[5] * q1.y) + (kx[6] * q1.z + kx[7] * q1.w); } } }
            else { valid = true; const int kb = WIN + t - dist;
                if (kb < WIN) { const float* kr = A.in[7] + ((size_t)b * WIN + kb) * 128 + kvh * 64;
#pragma unroll
                    for (int c = 0; c < 16; ++c) { const f32x4 kx = *(const GAS f32x4*)(kr + 4 * c), q0 = *(const LAS f32x4*)(qw + 4 * c); dot += (kx.x * q0.x + kx.y * q0.y) + (kx.z * q0.z + kx.w * q0.w); } }
                else { const bf16* kr = PROJ + ((size_t)TP + 4 * b + (kb - WIN)) * NPROJ + C_KA + kvh * 64;
#pragma unroll
                    for (int c = 0; c < 8; ++c) { float kx[8]; unpack8(*(const GAS v4u*)(kr + 8 * c), kx); const f32x4 q0 = *(const LAS f32x4*)(qw + 8 * c), q1 = *(const LAS f32x4*)(qw + 8 * c + 4);
                        dot += (kx[0] * q0.x + kx[1] * q0.y) + (kx[2] * q0.z + kx[3] * q0.w) + (kx[4] * q1.x + kx[5] * q1.y) + (kx[6] * q1.z + kx[7] * q1.w); } } }
            sc[jj] = dot + A.in[22][t5_bucket(dist) * 16 + head]; vl[jj] = valid;
        }
        float m = fmaxf(vl[0] ? sc[0] : -1e30f, vl[1] ? sc[1] : -1e30f); m = fmaxf(wave_max(m), sink);
        const float p0 = vl[0] ? expf(sc[0] - m) : 0.f, p1 = vl[1] ? expf(sc[1] - m) : 0.f;
        const float l = wave_sum(p0 + p1) + expf(sink - m), il = 1.0f / l;
        Pw[lane] = p0 * il; Pw[lane + 64] = p1 * il;
        WAVE_LDS_SYNC();
        float acc = 0.f;
        if (pr) { const int j0 = t >= 127 ? 0 : 127 - t;
            for (int j = j0; j < 128; ++j) acc += Pw[j] * bf2f(PROJ[((size_t)b * SEQ + (t - 127 + j)) * NPROJ + C_VA + kvh * 64 + lane]); }
        else { for (int j = 0; j < 128; ++j) { const int kb = WIN + t - (127 - j);
                const float vv = kb < WIN ? A.in[8][((size_t)b * WIN + kb) * 128 + kvh * 64 + lane] : bf2f(PROJ[((size_t)TP + 4 * b + (kb - WIN)) * NPROJ + C_VA + kvh * 64 + lane]);
                acc += Pw[j] * vv; } }
        MIX[(size_t)r * DM + 1024 + head * 64 + lane] = (bf16)f2bf(acc);
    }
}
__device__ __forceinline__ void naive_xattn(Frame& F, const Args& A) {
    unsigned char* ws = A.ws; const int lane = F.lane;
    const bf16* QX = (const bf16*)(ws + WS_QX); bf16* OX = (bf16*)(ws + WS_OX);
    LAS float* Pw = (LAS float*)(F.lds + F.wave * 16384); LAS float* qw = Pw + 256;
    for (int idx = F.gw; idx < TT * XH; idx += F.ngw) {
        const int head = idx & 3, r = idx >> 2; const bool pr = r < TP; const int b = pr ? r / SEQ : (r - TP) / DECS;
        const float* Kb = (pr ? A.out + O_PMK : A.in[9]) + (size_t)b * NMEM * XW + head * XHD;
        const float* Vb = (pr ? A.out + O_PMV : A.in[10]) + (size_t)b * NMEM * XW + head * XHD;
        const float q0 = bf2f(QX[(size_t)r * XW + head * XHD + lane]), q1 = bf2f(QX[(size_t)r * XW + head * XHD + lane + 64]);
        const float rs = 0.08838834764831845f / sqrtf(wave_sum(q0 * q0 + q1 * q1) * (1.f / 128.f) + EPS);
        WAVE_LDS_SYNC();
        qw[lane] = q0 * rs * A.in[28][lane]; qw[lane + 64] = q1 * rs * A.in[28][lane + 64];
        WAVE_LDS_SYNC();
        float sc[4];
#pragma unroll
        for (int jj = 0; jj < 4; ++jj) { const float* kr = Kb + (size_t)(lane + 64 * jj) * XW; float dot = 0.f;
#pragma unroll 8
            for (int c = 0; c < 32; ++c) { const f32x4 kx = *(const GAS f32x4*)(kr + 4 * c), qq = *(const LAS f32x4*)(qw + 4 * c); dot += (kx.x * qq.x + kx.y * qq.y) + (kx.z * qq.z + kx.w * qq.w); }
            sc[jj] = dot; }
        const float m = wave_max(fmaxf(fmaxf(sc[0], sc[1]), fmaxf(sc[2], sc[3])));
        float p[4], ls = 0.f;
#pragma unroll
        for (int jj = 0; jj < 4; ++jj) { p[jj] = expf(sc[jj] - m); ls += p[jj]; }
        const float il = 1.0f / wave_sum(ls);
#pragma unroll
        for (int jj = 0; jj < 4; ++jj) Pw[lane + 64 * jj] = p[jj] * il;
        WAVE_LDS_SYNC();
        float a0 = 0.f, a1 = 0.f;
#pragma unroll 4
        for (int j = 0; j < NMEM; ++j) { const float pj = Pw[j]; a0 += pj * Vb[(size_t)j * XW + lane]; a1 += pj * Vb[(size_t)j * XW + lane + 64]; }
        OX[(size_t)r * XW + head * XHD + lane] = (bf16)f2bf(a0); OX[(size_t)r * XW + head * XHD + lane + 64] = (bf16)f2bf(a1);
    }
}
constexpr int N_PHASES = 10;
#ifndef MK_ONE_LAUNCH
#define MK_ONE_LAUNCH 1
#endif
__global__ void __launch_bounds__(NTHR, 2) hymba_fwd(Args args) {
    extern __shared__ __attribute__((aligned(16))) unsigned char lds[];
    Frame F;
    F.lds = (LAS unsigned char*)lds; F.MISC = (volatile LAS unsigned*)(F.lds + MISC_OFF);
    F.tid = threadIdx.x; F.lane = F.tid & 63; F.wave = __builtin_amdgcn_readfirstlane(F.tid >> 6);
    F.G = gridDim.x; { const int bx = blockIdx.x; F.vcu = (F.G % 8 == 0) ? (bx % 8) * (F.G / 8) + bx / 8 : bx; }
    F.gw = F.vcu * NWAVES + F.wave; F.ngw = F.G * NWAVES;
    unsigned char* ws = args.ws; F.ctl = (gu32*)(ws + WS_CTL);
    for (int u = F.tid; u < (LDS_BYTES - LDSCTL_OFF) / 4; u += NTHR) ((LAS unsigned*)(F.lds + LDSCTL_OFF))[u] = 0u;
    __syncthreads();
    XcdBarrier bar; bar.bar = (unsigned*)(F.ctl + CW_BAR); bar.x = 0; bar.st = nullptr;
    const int lo = args.ph_lo, hi = args.ph_hi;
    if (hi - lo > 1) bar = xcd_barrier_post((unsigned*)(F.ctl + CW_BAR), F.MISC + 8);
#define IN(k) (lo <= (k) && (k) < hi)
#define SEAM(k) do { if (IN(k) && IN((k) + 1)) xcd_barrier(bar); } while (0)
    bf16* const H = (bf16*)(ws + WS_H); bf16* const PROJ = (bf16*)(ws + WS_PROJ); bf16* const MIX = (bf16*)(ws + WS_MIX);
    float* const RSS1 = (float*)(ws + WS_RSS1); float* const RSS2 = (float*)(ws + WS_RSS2);
    float* const OUT = args.out;

    if (IN(0)) { p0_prologue(F, args); SEAM(0); }
    if (IN(1)) {
        { pg8::Gemm g{H, (const bf16*)(ws + WS_WIN), TT, NPROJ, DM}; pg8::StaticOrder S; S.init(TT, NPROJ, F.G, (int)blockIdx.x);
          pg8::EpiBf16Plain E{PROJ, NPROJ};
          pg8::gemm_phase<pg8::EpiBf16Plain, pg8::StaticOrder, true, true>(F.lds, g, S, E); }
        { pg8::Gemm g{(const bf16*)(ws + WS_MN), (const bf16*)(ws + WS_WKV), BATCH * NMEM, 1024, DM}; pg8::StaticOrder S; S.init(BATCH * NMEM, 1024, F.G, (int)((blockIdx.x + F.G - 66 % F.G) % F.G));
          pg8::EpiF32Plain E{(float*)(ws + WS_MKV), 1024};
          pg8::gemm_phase<pg8::EpiF32Plain, pg8::StaticOrder, true, true>(F.lds, g, S, E); }
        SEAM(1);
    }
    if (IN(2)) { p2_prep(F, args); SEAM(2); }
    if (IN(3)) { naive_mlstm_prompt(F, args); naive_mlstm_prompt_state(F, args); naive_mlstm_sample(F, args); naive_swa(F, args); __syncthreads(); SEAM(3); }
    if (IN(4)) {
        pg8::Gemm g{MIX, (const bf16*)(ws + WS_WOUT), TT, DM, DM}; pg8::StaticOrder S; S.init(TT, DM, F.G, (int)blockIdx.x);
        pg8::EpiResid<true> E{args.in[0], args.in[1], TP, OUT, H, RSS1, DM};
        pg8::gemm_phase<pg8::EpiResid<true>, pg8::StaticOrder, true, true>(F.lds, g, S, E);
        SEAM(4);
    }
    if (IN(5)) {
        pg8::Gemm g{H, (const bf16*)(ws + WS_WQ), TT, XW, DM}; pg8::StaticOrder S; S.init(TT, XW, F.G, (int)blockIdx.x);
        pg8::EpiScaleBf16<0> E{(bf16*)(ws + WS_QX), XW, RSS1, 1.0f / DM, EPS};
        pg8::gemm_phase<pg8::EpiScaleBf16<0>, pg8::StaticOrder, true, true>(F.lds, g, S, E);
        SEAM(5);
    }
    if (IN(6)) { naive_xattn(F, args); __syncthreads(); SEAM(6); }
    if (IN(7)) {
        pg8::Gemm g{(const bf16*)(ws + WS_OX), (const bf16*)(ws + WS_WO), TT, DM, XW}; pg8::StaticOrder S; S.init(TT, DM, F.G, (int)blockIdx.x);
        pg8::EpiResid<true> E{OUT, OUT, TT, OUT, H, RSS2, DM};
        pg8::gemm_phase<pg8::EpiResid<true>, pg8::StaticOrder, true, true>(F.lds, g, S, E);
        SEAM(7);
    }
    if (IN(8)) {
        pg8::Gemm g{H, (const bf16*)(ws + WS_WUP), TT, DFF, DM}; pg8::StaticOrder S; S.init(TT, DFF, F.G, (int)blockIdx.x);
        pg8::EpiScaleBf16<1> E{(bf16*)(ws + WS_U2), DFF, RSS2, 1.0f / DM, EPS};
        pg8::gemm_phase<pg8::EpiScaleBf16<1>, pg8::StaticOrder, true, true>(F.lds, g, S, E);
        SEAM(8);
    }
    if (IN(9)) {
        pg8::Gemm g{(const bf16*)(ws + WS_U2), (const bf16*)(ws + WS_WDN), TT, DM, DFF}; pg8::StaticOrder S; S.init(TT, DM, F.G, (int)blockIdx.x);
        pg8::EpiResid<false> E{OUT, OUT, TT, OUT, nullptr, nullptr, DM};
        pg8::gemm_phase<pg8::EpiResid<false>, pg8::StaticOrder, true, true>(F.lds, g, S, E);
    }
#undef IN
#undef SEAM
}

extern "C" void kernel_launch(void* const* d_in, const int* in_sizes, int n_in, void* d_out, int out_size, void* d_ws, size_t ws_size, hipStream_t stream) {
    static int grid = 0;
    if (grid == 0) {
        if (n_in != 34 || (size_t)out_size != O_END || ws_size < WS_END) { fprintf(stderr, "kernel_launch: unexpected shapes: n_in %d out %d (want %zu) ws %zu (want %zu)\n", n_in, out_size, (size_t)O_END, ws_size, (size_t)WS_END); grid = -1; return; }
        int dev = 0, cus = 0;
        if (hipGetDevice(&dev) != hipSuccess || hipDeviceGetAttribute(&cus, hipDeviceAttributeMultiprocessorCount, dev) != hipSuccess) { grid = -1; return; }
        if (hipFuncSetAttribute((const void*)hymba_fwd, hipFuncAttributeMaxDynamicSharedMemorySize, LDS_BYTES) != hipSuccess) { fprintf(stderr, "kernel_launch: hipFuncSetAttribute failed\n"); grid = -1; return; }
        (void)hipGetLastError();
        grid = cus;
    }
    if (grid < 0) return;
    (void)hipMemsetAsync((char*)d_ws + WS_CTL, 0, CTL_ZERO_BYTES, stream);
    Args a{};
    for (int i = 0; i < 34; ++i) a.in[i] = (const float*)d_in[i];
    a.out = (float*)d_out; a.ws = (unsigned char*)d_ws;
#if MK_ONE_LAUNCH
    a.ph_lo = 0; a.ph_hi = N_PHASES;
    hipLaunchKernelGGL(hymba_fwd, dim3(grid), dim3(NTHR), LDS_BYTES, stream, a);
#else
    for (int p = 0; p < N_PHASES; ++p) { a.ph_lo = p; a.ph_hi = p + 1; hipLaunchKernelGGL(hymba_fwd, dim3(grid), dim3(NTHR), LDS_BYTES, stream, a); }
#endif
}
```

```cpp
#include <hip/hip_runtime.h>
#include <cstdio>
#include <cstdint>
namespace pg8 {
#define PG8_LAS __attribute__((address_space(3)))
typedef unsigned short bf16_t;
typedef short bf16x8 __attribute__((ext_vector_type(8)));
typedef float f32x4 __attribute__((ext_vector_type(4)));
typedef unsigned u32x4 __attribute__((ext_vector_type(4)));
constexpr int BM = 256, BK = 64, HALF = 128, HTB = HALF * BK * 2  , STAGE_BYTES = 8 * HTB, NXCD = 8, WGM = 8;

__host__ __device__ __forceinline__ int lds_byte(int r, int c) { const int st = (r >> 4) * 2 + (c >> 5), rr = r & 15, cc = c & 31, ob = rr * 64 + cc * 2; return st * 1024 + (ob ^ (((ob >> 9) & 1) << 5)); }
__host__ __device__ __forceinline__ void stage_rc(int b, int& R, int& C) { const int st = b / 1024, sb = b % 1024, swz = sb ^ (((sb >> 9) & 1) << 5); R = (st >> 1) * 16 + swz / 64; C = (st & 1) * 32 + (swz % 64) / 2; }
__host__ __device__ __forceinline__ int perm32(int rho) { const int n = rho >> 4, i = rho & 15; return 8 * (i >> 2) + 4 * n + (i & 3); }

struct Unit { int pm, pn; };
struct Gemm { const bf16_t* A; const bf16_t* Bt; int M, N, K; };

struct StaticOrder {
    int nM, nN, nwg, G, c;
    __host__ __device__ void init(int M, int N, int G_, int c_) { nM = M / BM; nN = N / BM; nwg = nM * nN; G = G_; c = c_; }
    __host__ __device__ bool next(int i, Unit& u) const {
        const long L = (long)i * G + c; if (L >= nwg) return false;
        int wgid = (int)L; { const int q = nwg / NXCD, r = nwg % NXCD, xcd = wgid % NXCD, off = wgid / NXCD; wgid = (xcd < r ? xcd * (q + 1) : r * (q + 1) + (xcd - r) * q) + off; }
        const int nig = WGM * nN, gid = wgid / nig, fm = gid * WGM, gsz = (nM - fm) < WGM ? (nM - fm) : WGM;
        u.pm = fm + ((wgid % nig) % gsz); u.pn = (wgid % nig) / gsz; return true;
    }
    __device__ __forceinline__ void a_ready(const Unit&) const {}
    __device__ __forceinline__ void done(const Unit&) const {}
};

__device__ __forceinline__ unsigned cvt_pk_bf16(float lo, float hi) { unsigned r; asm volatile("v_cvt_pk_bf16_f32 %0, %1, %2" : "=v"(r) : "v"(lo), "v"(hi)); return r; }
typedef float f32x2 __attribute__((ext_vector_type(2)));
template <class Epi, class Sched, bool ALIGN_EPI = false, bool SP2 = false>
__device__ __forceinline__ void gemm_phase(PG8_LAS unsigned char* lds, const Gemm g, const Sched& S, const Epi& E) {
    const int tid = threadIdx.x, wid = __builtin_amdgcn_readfirstlane(tid >> 6), lane = tid & 63, wr = wid >> 2, wc = wid & 3, fr = lane & 15, fq = lane >> 4;
    const int K = g.K, nt = K / BK;
    unsigned voffA[2], voffB[2];
#pragma unroll
    for (int i = 0; i < 2; ++i) { int R, C; stage_rc(tid * 16 + i * 8192, R, C); const int Rb = Epi::PERM ? ((R & ~31) + perm32(R & 31)) : R;
        voffA[i] = (unsigned)(R * K + C) * 2u; voffB[i] = (unsigned)(Rb * K + C) * 2u; }
    const size_t kstep = (size_t)(BK * 2);
    const size_t hstep = (size_t)HALF * K * 2;
    const size_t tstep = 2 * hstep;
    const unsigned ldsw = (unsigned)wid * 1024u;
    const int aoff = lds_byte(wr * 64 + fr, fq * 8), boff = lds_byte(wc * 32 + fr, fq * 8);
#define PG8_SA(b, h) (((b) * 2 + (h)) * HTB)
#define PG8_SB(b, h) ((4 + (b) * 2 + (h)) * HTB)
#define PG8_STAGE(bufoff, gbase, voff) do { _Pragma("unroll") for (int _i = 0; _i < 2; ++_i) \
        __builtin_amdgcn_global_load_lds((const unsigned*)((const char*)(gbase) + (voff)[_i]), (PG8_LAS unsigned*)(lds + (bufoff) + ldsw + _i * 8192), 16, 0, 0); } while (0)
#define PG8_LDA(dst, b, h) do { _Pragma("unroll") for (int m = 0; m < 4; ++m) _Pragma("unroll") for (int k = 0; k < 2; ++k) dst[m][k] = *(const PG8_LAS bf16x8*)(lds + PG8_SA(b, h) + aoff + m * 2048 + k * 1024); } while (0)
#define PG8_LDB(dst, b, h) do { _Pragma("unroll") for (int n = 0; n < 2; ++n) _Pragma("unroll") for (int k = 0; k < 2; ++k) dst[n][k] = *(const PG8_LAS bf16x8*)(lds + PG8_SB(b, h) + boff + n * 2048 + k * 1024); } while (0)
#define PG8_MMA(ai, bj, At, Bt) do { __builtin_amdgcn_s_setprio(1); _Pragma("unroll") for (int m = 0; m < 4; ++m) _Pragma("unroll") for (int n = 0; n < 2; ++n) _Pragma("unroll") for (int k = 0; k < 2; ++k) \
        acc[ai][bj][m][n] = __builtin_amdgcn_mfma_f32_16x16x32_bf16(Bt[n][k], At[m][k], acc[ai][bj][m][n], 0, 0, 0); __builtin_amdgcn_s_setprio(0); } while (0)
#define PG8_WAIT_V(n) asm volatile("s_waitcnt vmcnt(" #n ")" ::: "memory")
#define PG8_WAIT_L(n) asm volatile("s_waitcnt lgkmcnt(" #n ")" ::: "memory")
#define PG8_BAR __builtin_amdgcn_s_barrier()
#define PG8_SCHED __builtin_amdgcn_sched_barrier(0)
    Unit cur, nxt; int ui = 0;
    if (!S.next(0, cur)) return;
    f32x4 acc[2][2][4][2];
#pragma unroll
    for (int a = 0; a < 2; ++a)
#pragma unroll
        for (int b = 0; b < 2; ++b)
#pragma unroll
            for (int m = 0; m < 4; ++m)
#pragma unroll
                for (int n = 0; n < 2; ++n) acc[a][b][m][n] = (f32x4){0.f, 0.f, 0.f, 0.f};
    bf16x8 At[4][2], B0[2][2], B1[2][2];
    const char* cA = (const char*)g.A + (size_t)cur.pm * tstep; const char* cB = (const char*)g.Bt + (size_t)cur.pn * tstep;
    S.a_ready(cur);
    if constexpr (SP2) {
        PG8_STAGE(PG8_SB(0, 0), cB, voffB); PG8_STAGE(PG8_SB(0, 1), cB + hstep, voffB); PG8_STAGE(PG8_SA(0, 0), cA, voffA); PG8_STAGE(PG8_SA(0, 1), cA + hstep, voffA);
        if (wr == 1) PG8_BAR;
        PG8_WAIT_V(2); PG8_BAR;
        PG8_STAGE(PG8_SB(1, 0), cB + kstep, voffB); PG8_STAGE(PG8_SA(1, 0), cA + kstep, voffA); PG8_STAGE(PG8_SB(1, 1), cB + hstep + kstep, voffB);
        PG8_WAIT_V(6); PG8_BAR;
    } else {
        PG8_STAGE(PG8_SB(0, 0), cB, voffB); PG8_STAGE(PG8_SA(0, 0), cA, voffA); PG8_STAGE(PG8_SB(0, 1), cB + hstep, voffB); PG8_STAGE(PG8_SA(0, 1), cA + hstep, voffA);
        if (wr == 1) PG8_BAR;
        PG8_WAIT_V(4); PG8_BAR;
        PG8_STAGE(PG8_SB(1, 0), cB + kstep, voffB); PG8_STAGE(PG8_SA(1, 0), cA + kstep, voffA); PG8_STAGE(PG8_SB(1, 1), cB + hstep + kstep, voffB);
        PG8_WAIT_V(6); PG8_BAR;
    }
    for (;;) {
        const bool has_next = S.next(ui + 1, nxt);
        const char* nA = has_next ? (const char*)g.A + (size_t)nxt.pm * tstep : cA; const char* nB = has_next ? (const char*)g.Bt + (size_t)nxt.pn * tstep : cB;
        for (int t = 0; t < nt; t += 2) {
            const bool last = (t == nt - 2);
            const char* a1 = cA + (size_t)(t + 1) * kstep;
            const char* a2 = last ? nA : cA + (size_t)(t + 2) * kstep; const char* b2 = last ? nB : cB + (size_t)(t + 2) * kstep;
            const char* a3 = a2 + kstep; const char* b3 = b2 + kstep;
            if (last && has_next) S.a_ready(nxt);
            if constexpr (SP2) {
            PG8_LDB(B0, 0, 0); PG8_LDB(B1, 0, 1); PG8_SCHED; PG8_LDA(At, 0, 0); PG8_STAGE(PG8_SA(1, 1), a1 + hstep, voffA);
            PG8_WAIT_V(8); PG8_WAIT_L(0); PG8_BAR; PG8_MMA(0, 0, At, B0); PG8_MMA(0, 1, At, B1); PG8_BAR; PG8_SCHED;
            PG8_LDA(At, 0, 1); PG8_STAGE(PG8_SB(0, 0), b2, voffB); PG8_STAGE(PG8_SB(0, 1), b2 + hstep, voffB); PG8_STAGE(PG8_SA(0, 0), a2, voffA);
            PG8_WAIT_V(8); PG8_WAIT_L(0); PG8_BAR; PG8_MMA(1, 0, At, B0); PG8_MMA(1, 1, At, B1); PG8_BAR; PG8_SCHED;
            PG8_LDB(B0, 1, 0); PG8_LDB(B1, 1, 1); PG8_SCHED; PG8_LDA(At, 1, 0); PG8_STAGE(PG8_SA(0, 1), a2 + hstep, voffA);
            PG8_WAIT_V(8); PG8_WAIT_L(0); PG8_BAR; PG8_MMA(0, 0, At, B0); PG8_MMA(0, 1, At, B1); PG8_BAR; PG8_SCHED;
            PG8_LDA(At, 1, 1); PG8_STAGE(PG8_SB(1, 0), b3, voffB); PG8_STAGE(PG8_SB(1, 1), b3 + hstep, voffB); PG8_STAGE(PG8_SA(1, 0), a3, voffA);
            PG8_WAIT_V(8); PG8_WAIT_L(0); PG8_BAR; PG8_MMA(1, 0, At, B0); PG8_MMA(1, 1, At, B1); PG8_BAR; PG8_SCHED;
            } else {
            PG8_LDB(B0, 0, 0); PG8_SCHED; PG8_LDA(At, 0, 0); PG8_STAGE(PG8_SA(1, 1), a1 + hstep, voffA);
            PG8_WAIT_L(8); PG8_BAR; PG8_WAIT_L(0); PG8_MMA(0, 0, At, B0); PG8_BAR; PG8_SCHED;
            PG8_LDB(B1, 0, 1); PG8_STAGE(PG8_SB(0, 0), b2, voffB);
            PG8_BAR; PG8_WAIT_L(0); PG8_MMA(0, 1, At, B1); PG8_BAR;
            PG8_LDA(At, 0, 1); PG8_STAGE(PG8_SA(0, 0), a2, voffA);
            PG8_BAR; PG8_WAIT_L(0); PG8_MMA(1, 0, At, B0); PG8_BAR; PG8_SCHED;
            PG8_STAGE(PG8_SB(0, 1), b2 + hstep, voffB);
            PG8_WAIT_V(6); PG8_BAR; PG8_MMA(1, 1, At, B1); PG8_BAR;
            PG8_LDB(B0, 1, 0); PG8_SCHED; PG8_LDA(At, 1, 0); PG8_STAGE(PG8_SA(0, 1), a2 + hstep, voffA);
            PG8_WAIT_L(8); PG8_BAR; PG8_WAIT_L(0); PG8_MMA(0, 0, At, B0); PG8_BAR; PG8_SCHED;
            PG8_LDB(B1, 1, 1); PG8_STAGE(PG8_SB(1, 0), b3, voffB);
            PG8_BAR; PG8_WAIT_L(0); PG8_MMA(0, 1, At, B1); PG8_BAR;
            PG8_LDA(At, 1, 1); PG8_STAGE(PG8_SA(1, 0), a3, voffA);
            PG8_BAR; PG8_WAIT_L(0); PG8_MMA(1, 0, At, B0); PG8_BAR; PG8_SCHED;
            PG8_STAGE(PG8_SB(1, 1), b3 + hstep, voffB);
            PG8_WAIT_V(6); PG8_BAR; PG8_MMA(1, 1, At, B1); PG8_BAR;
            }
        }
        if constexpr (ALIGN_EPI) { if (wr == 0) PG8_BAR; }
        if constexpr (!Epi::AFTER_DRAIN) { E(acc, cur, wr, wc, fr, fq); S.done(cur); }
        if (!has_next) break;
#pragma unroll
        for (int a = 0; a < 2; ++a)
#pragma unroll
            for (int b = 0; b < 2; ++b)
#pragma unroll
                for (int m = 0; m < 4; ++m)
#pragma unroll
                    for (int n = 0; n < 2; ++n) acc[a][b][m][n] = (f32x4){0.f, 0.f, 0.f, 0.f};
        cur = nxt; cA = nA; cB = nB; ++ui;
        if constexpr (ALIGN_EPI) { if (wr == 1) PG8_BAR; }
    }
    PG8_WAIT_V(0);
    if constexpr (!ALIGN_EPI) { if (wr == 0) PG8_BAR; }
    PG8_BAR;
    if constexpr (Epi::AFTER_DRAIN) { E.fused(acc, cur, wr, wc, fr, fq, lds, wid, lane); S.done(cur); }
#undef PG8_SA
#undef PG8_SB
#undef PG8_STAGE
#undef PG8_LDA
#undef PG8_LDB
#undef PG8_MMA
#undef PG8_WAIT_V
#undef PG8_WAIT_L
#undef PG8_BAR
#undef PG8_SCHED
}
}
namespace pg8 {
typedef unsigned u32x2 __attribute__((ext_vector_type(2)));
struct EpiBf16Plain {
    static constexpr bool PERM = true, AFTER_DRAIN = false;
    bf16_t* O; int ldc;
    __device__ __forceinline__ void operator()(const f32x4 (&acc)[2][2][4][2], const Unit& u, int wr, int wc, int fr, int fq) const {
        const int row0 = u.pm * BM + wr * 64 + fr, col0 = u.pn * BM + wc * 32 + 8 * fq;
#pragma unroll
        for (int ai = 0; ai < 2; ++ai)
#pragma unroll
            for (int m = 0; m < 4; ++m) { bf16_t* rowp = O + (size_t)(row0 + ai * HALF + m * 16) * ldc + col0;
#pragma unroll
                for (int bj = 0; bj < 2; ++bj) { const f32x4 v0 = acc[ai][bj][m][0], v1 = acc[ai][bj][m][1];
                    u32x4 w; w.x = cvt_pk_bf16(v0[0], v0[1]); w.y = cvt_pk_bf16(v0[2], v0[3]); w.z = cvt_pk_bf16(v1[0], v1[1]); w.w = cvt_pk_bf16(v1[2], v1[3]);
                    *(u32x4*)(rowp + bj * HALF) = w; } }
    }
};
struct EpiF32Plain {
    static constexpr bool PERM = false, AFTER_DRAIN = false;
    float* C; int ldc;
    __device__ __forceinline__ void operator()(const f32x4 (&acc)[2][2][4][2], const Unit& u, int wr, int wc, int fr, int fq) const {
        const int row0 = u.pm * BM + wr * 64 + fr, col0 = u.pn * BM + wc * 32 + 4 * fq;
#pragma unroll
        for (int ai = 0; ai < 2; ++ai)
#pragma unroll
            for (int m = 0; m < 4; ++m) { float* rowp = C + (size_t)(row0 + ai * HALF + m * 16) * ldc + col0;
#pragma unroll
                for (int bj = 0; bj < 2; ++bj)
#pragma unroll
                    for (int n = 0; n < 2; ++n) *(f32x4*)(rowp + bj * HALF + n * 16) = acc[ai][bj][m][n]; }
    }
};
template <bool WITH_XB> struct EpiResid {
    static constexpr bool PERM = false, AFTER_DRAIN = false;
    const float* r0; const float* r1; int split_row; float* out; bf16_t* xb; float* rowss; int ldc;
    __device__ __forceinline__ void operator()(const f32x4 (&acc)[2][2][4][2], const Unit& u, int wr, int wc, int fr, int fq) const {
        const int row0 = u.pm * BM + wr * 64 + fr, col0 = u.pn * BM + wc * 32 + 4 * fq;
#pragma unroll
        for (int ai = 0; ai < 2; ++ai)
#pragma unroll
            for (int m = 0; m < 4; ++m) { const int row = row0 + ai * HALF + m * 16;
                const float* rp = (row < split_row ? r0 + (size_t)row * ldc : r1 + (size_t)(row - split_row) * ldc) + col0;
                float* op = out + (size_t)row * ldc + col0; float ss = 0.f;
#pragma unroll
                for (int bj = 0; bj < 2; ++bj)
#pragma unroll
                    for (int n = 0; n < 2; ++n) { const f32x4 o = *(const f32x4*)(rp + bj * HALF + n * 16) + acc[ai][bj][m][n];
                        *(f32x4*)(op + bj * HALF + n * 16) = o;
                        if (WITH_XB) { ss += (o[0] * o[0] + o[1] * o[1]) + (o[2] * o[2] + o[3] * o[3]);
                            u32x2 w; w.x = cvt_pk_bf16(o[0], o[1]); w.y = cvt_pk_bf16(o[2], o[3]);
                            *(u32x2*)(xb + (size_t)row * ldc + col0 + bj * HALF + n * 16) = w; } }
                if (WITH_XB) { ss += __shfl_xor(ss, 16); ss += __shfl_xor(ss, 32); if (fq == 0) atomicAdd(rowss + row, ss); } }
    }
};
template <int ACT> struct EpiScaleBf16 {
    static constexpr bool PERM = true, AFTER_DRAIN = false;
    bf16_t* O; int ldc; const float* rowss; float inv_k, eps;
    __device__ __forceinline__ void operator()(const f32x4 (&acc)[2][2][4][2], const Unit& u, int wr, int wc, int fr, int fq) const {
        const int row0 = u.pm * BM + wr * 64 + fr, col0 = u.pn * BM + wc * 32 + 8 * fq;
#pragma unroll
        for (int ai = 0; ai < 2; ++ai)
#pragma unroll
            for (int m = 0; m < 4; ++m) { const int row = row0 + ai * HALF + m * 16; bf16_t* rowp = O + (size_t)row * ldc + col0;
                const float rs = 1.0f / sqrtf(rowss[row] * inv_k + eps);
#pragma unroll
                for (int bj = 0; bj < 2; ++bj) { f32x4 v0 = acc[ai][bj][m][0] * rs, v1 = acc[ai][bj][m][1] * rs;
                    if (ACT == 1) {
#pragma unroll
                        for (int e = 0; e < 4; ++e) { const float a = fmaxf(v0[e], 0.f), b = fmaxf(v1[e], 0.f); v0[e] = a * a; v1[e] = b * b; } }
                    u32x4 w; w.x = cvt_pk_bf16(v0[0], v0[1]); w.y = cvt_pk_bf16(v0[2], v0[3]); w.z = cvt_pk_bf16(v1[0], v1[1]); w.w = cvt_pk_bf16(v1[2], v1[3]);
                    *(u32x4*)(rowp + bj * HALF) = w; } }
    }
};
}
#define GAS __attribute__((address_space(1)))
#define LAS __attribute__((address_space(3)))
typedef unsigned short bf16;
typedef unsigned v4u __attribute__((ext_vector_type(4)));
typedef float f32x4 __attribute__((ext_vector_type(4)));
typedef short bf16x8 __attribute__((ext_vector_type(8)));
typedef GAS unsigned gu32;
typedef GAS unsigned long long gu64;
#define RLX_AGENT __ATOMIC_RELAXED, __HIP_MEMORY_SCOPE_AGENT
#define LDS_WAIT() asm volatile("s_waitcnt lgkmcnt(0)" ::: "memory")
#define VM_WAIT() asm volatile("s_waitcnt vmcnt(0)" ::: "memory")
__device__ __forceinline__ unsigned long long rt() { return __builtin_amdgcn_s_memrealtime(); }
__device__ __forceinline__ unsigned f2bf(float f) { unsigned u = __builtin_bit_cast(unsigned, f); return (u + 0x7fffu + ((u >> 16) & 1u)) >> 16; }
__device__ __forceinline__ unsigned pk2(float lo, float hi) { return f2bf(lo) | (f2bf(hi) << 16); }
#define XB_TMO      128
#define XB_XCNT(j)  (256  + 64 * (j))
#define XB_XSUB(j)  (1280 + 64 * (j))
#define XB_XGEN(j)  (2304 + 64 * (j))
#define XB_TOP      3328
#define XB_TOPGEN   3392
#define XCD_BAR_WORDS 3456
#define XB_SPIN_CAP (1u << 18)

__device__ __forceinline__ unsigned xb_ld(unsigned* p)              { return __hip_atomic_load(p, __ATOMIC_RELAXED, __HIP_MEMORY_SCOPE_AGENT); }
__device__ __forceinline__ unsigned xb_add(unsigned* p, unsigned v) { return __hip_atomic_fetch_add(p, v, __ATOMIC_RELAXED, __HIP_MEMORY_SCOPE_AGENT); }
__device__ __forceinline__ unsigned xb_xcc_id() { return (unsigned)__builtin_amdgcn_s_getreg((3 << 11) | 20) & 0xFu; }
#define XB_SPIN(cond, bar) do { unsigned _sp = 0; while (cond) { __builtin_amdgcn_s_sleep(1); \
    if ((++_sp & 255u) == 0u) { if (xb_ld(&(bar)[XB_TMO])) break; if (_sp > XB_SPIN_CAP) { atomicAdd(&(bar)[XB_TMO], 1u); break; } } } } while (0)

struct XcdBarrier {
    unsigned* bar; unsigned x;
    volatile LAS unsigned* st;
};

__device__ __forceinline__ XcdBarrier xcd_barrier_post(unsigned* bar, volatile LAS unsigned* st) {
    XcdBarrier b; b.bar = bar; b.x = xb_xcc_id(); b.st = st;
    if (threadIdx.x == 0) (void)xb_add(&bar[XB_XCNT(b.x)], 1u);
    return b;
}
__device__ __forceinline__ void xcd_barrier_complete(unsigned* bar, unsigned x, unsigned& nloc, unsigned& nx) {
    const unsigned G = gridDim.x * gridDim.y * gridDim.z;
    unsigned sum, cnt, mine, sp = 0u;
    for (;;) {
        sum = 0u; cnt = 0u; mine = 0u;
#pragma unroll
        for (unsigned j = 0; j < 16; ++j) { const unsigned c = xb_ld(&bar[XB_XCNT(j)]); sum += c; cnt += (c > 0u) ? 1u : 0u; mine = (j == x) ? c : mine; }
        if (sum == G) break;
        __builtin_amdgcn_s_sleep(1);
        if ((++sp & 255u) == 0u) { if (xb_ld(&bar[XB_TMO])) break; if (sp > XB_SPIN_CAP) { atomicAdd(&bar[XB_TMO], 1u); break; } }
    }
    nloc = mine > 0u ? mine : 1u; nx = cnt > 0u ? cnt : 1u;
}

__device__ __forceinline__ void xcd_barrier(const XcdBarrier& b) {
    asm volatile("s_waitcnt vmcnt(0)" ::: "memory");
    __syncthreads();
    if (threadIdx.x == 0) {
        unsigned* bar = b.bar;
        __builtin_amdgcn_s_waitcnt(0);
        unsigned nloc = b.st[0], nx = b.st[1];
        if (nloc == 0u) { xcd_barrier_complete(bar, b.x, nloc, nx); b.st[0] = nloc; b.st[1] = nx; }
        const unsigned old = xb_add(&bar[XB_XSUB(b.x)], 1u);
        const unsigned gen = old / nloc;
        if (old + 1u == (gen + 1u) * nloc) {
            __builtin_amdgcn_fence(__ATOMIC_RELEASE, "agent");
            asm volatile("s_waitcnt vmcnt(0)" ::: "memory");
            const unsigned og = xb_add(&bar[XB_TOP], 1u);
            const unsigned tg = og / nx;
            if (og + 1u == (tg + 1u) * nx) xb_add(&bar[XB_TOPGEN], 1u);
            else XB_SPIN(xb_ld(&bar[XB_TOPGEN]) == tg, bar);
            __builtin_amdgcn_fence(__ATOMIC_ACQUIRE, "agent");
            xb_add(&bar[XB_XGEN(b.x)], 1u);
            asm volatile("s_waitcnt vmcnt(0)" ::: "memory");
        } else {
            XB_SPIN(xb_ld(&bar[XB_XGEN(b.x)]) == gen, bar);
            __builtin_amdgcn_fence(__ATOMIC_ACQUIRE, "agent");
            asm volatile("s_waitcnt vmcnt(0)" ::: "memory");
        }
    }
    __syncthreads();
}
constexpr int NWAVES = 8, NTHR = NWAVES * 64;
constexpr int DM = 2048, BATCH = 4, SEQ = 2048, DECB = 128, DECS = 4;
constexpr int TP = BATCH * SEQ, TS = DECB * DECS, TT = TP + TS;
constexpr int MH = 4, MDK = 128, MDV = 256, MQK = 512, MV = 1024;
constexpr int AH = 16, AKV = 2, AHD = 64, WIN = 128;
constexpr int XH = 4, XHD = 128, XW = 512, NMEM = 256;
constexpr int DFF = 8192, PIN = 4360, NPROJ = 4352;
constexpr int C_QK = 0, C_VM = 1024, C_OM = 2048, C_QA = 3072, C_KA = 4096, C_VA = 4224;
constexpr float EPS = 1e-6f;
constexpr float LOG2E = 1.4426950408889634f;
constexpr size_t O_YP = 0, O_YS = O_YP + (size_t)TP * DM, O_PCONV = O_YS + (size_t)TS * DM, O_PC = O_PCONV + 4 * 3 * 1024, O_PN = O_PC + 4 * 4 * 128 * 256,
    O_PM = O_PN + 4 * 4 * 128, O_PSK = O_PM + 16, O_PSV = O_PSK + 4 * 128 * 128, O_PMK = O_PSV + 4 * 128 * 128, O_PMV = O_PMK + 4 * 256 * 512,
    O_SCONV = O_PMV + 4 * 256 * 512, O_SC = O_SCONV + 128 * 3 * 1024, O_SN = O_SC + (size_t)128 * 4 * 128 * 256, O_SM = O_SN + 128 * 4 * 128,
    O_SSK = O_SM + 512, O_SSV = O_SSK + (size_t)128 * 128 * 128, O_END = O_SSV + (size_t)128 * 128 * 128;
constexpr size_t MiB = 1u << 20;
constexpr size_t WS_CTL = 0, CTL_ZERO_BYTES = 2 * MiB;
constexpr size_t WS_RSS1 = 1 * MiB, WS_RSS2 = 1 * MiB + 64 * 1024;
constexpr size_t WS_GATES = 2 * MiB;
constexpr size_t WS_GB = 3 * MiB, WS_GM = 3 * MiB + 128 * 1024;
constexpr size_t WS_MKV = 4 * MiB;
constexpr size_t WS_WIN = 8 * MiB, WS_WOUT = 25 * MiB, WS_WQ = 33 * MiB, WS_WKV = 35 * MiB, WS_WO = 39 * MiB, WS_WUP = 41 * MiB, WS_WDN = 73 * MiB;
constexpr size_t WS_H = 105 * MiB;
constexpr size_t WS_MN = 139 * MiB;
constexpr size_t WS_QX = 143 * MiB, WS_OX = 152 * MiB;
constexpr size_t WS_PROJ = 161 * MiB, WS_QKM = 234 * MiB, WS_MIX = 251 * MiB;
constexpr size_t WS_U2 = 161 * MiB;
constexpr size_t WS_SLAB = 297 * MiB, WS_UN = 329 * MiB;
constexpr size_t WS_END = 330 * MiB;
static_assert(WS_WIN + (size_t)NPROJ * DM * 2 <= WS_WOUT && WS_PROJ + (size_t)TT * NPROJ * 2 <= WS_QKM && WS_QKM + (size_t)TT * 1024 * 2 <= WS_MIX && WS_MIX + (size_t)TT * DM * 2 <= WS_END && WS_U2 + (size_t)TT * DFF * 2 <= WS_END, "ws map");
static_assert(WS_H + (size_t)TT * DM * 2 <= WS_MN && WS_QX + (size_t)TT * XW * 2 <= WS_OX && WS_OX + (size_t)TT * XW * 2 <= WS_PROJ, "ws map 2");
constexpr int CW_BAR = 4096;
constexpr int LDS_BYTES = 163840, RING_BYTES = LDS_BYTES - 512, LDSCTL_OFF = RING_BYTES, MISC_OFF = LDSCTL_OFF + 320;

struct Args { const float* in[34]; float* out; unsigned char* ws; int ph_lo, ph_hi; };

struct Frame {
    LAS unsigned char* lds; volatile LAS unsigned* MISC; gu32* ctl;
    int tid, lane, wave, vcu, G, gw, ngw;
};
__device__ __forceinline__ float wave_sum(float v) {
#pragma unroll
    for (int o = 1; o < 64; o <<= 1) v += __shfl_xor(v, o);
    return v;
}
__device__ __forceinline__ float wave_max(float v) {
#pragma unroll
    for (int o = 1; o < 64; o <<= 1) v = fmaxf(v, __shfl_xor(v, o));
    return v;
}
__device__ __forceinline__ float bf2f(unsigned short b) { return __builtin_bit_cast(float, (unsigned)b << 16); }
__device__ __forceinline__ float bflo(unsigned w) { return __builtin_bit_cast(float, w << 16); }
__device__ __forceinline__ float bfhi(unsigned w) { return __builtin_bit_cast(float, w & 0xffff0000u); }
__device__ __forceinline__ float logsigmoidf(float x) { return fminf(x, 0.f) - log1pf(expf(-fabsf(x))); }
__device__ __forceinline__ float sigmoidf_(float x) { return 1.0f / (1.0f + expf(-x)); }

__device__ __forceinline__ void p0_transpose_item(const float* W, int K, int ldw, int nsrc0, bf16* WT, int ndst0, const float* gain, LAS float* scr, int k0, int lane) {
#pragma unroll 8
    for (int i = 0; i < 32; ++i) { const int kk = 2 * i + (lane >> 5); float v = W[(size_t)(k0 + kk) * ldw + nsrc0 + (lane & 31)]; if (gain) v *= gain[k0 + kk]; scr[kk * 33 + (lane & 31)] = v; }
    LDS_WAIT(); asm volatile("" ::: "memory");
    const int c = lane & 7;
#pragma unroll
    for (int j = 0; j < 4; ++j) { const int n = (lane >> 3) + 8 * j; const LAS float* s = scr + (8 * c) * 33 + n;
        v4u o; o.x = pk2(s[0 * 33], s[1 * 33]); o.y = pk2(s[2 * 33], s[3 * 33]); o.z = pk2(s[4 * 33], s[5 * 33]); o.w = pk2(s[6 * 33], s[7 * 33]);
        *(GAS v4u*)(WT + (size_t)(ndst0 + n) * K + k0 + 8 * c) = o; }
    LDS_WAIT(); asm volatile("" ::: "memory");
}
__device__ __forceinline__ void p0_prologue(Frame& F, const Args& A) {
    unsigned char* ws = A.ws;
    LAS float* scr = (LAS float*)(F.lds + F.wave * 16384);
    constexpr int I_IN = 32 * (NPROJ / 32), I_OUT = 32 * 64, I_Q = 32 * 16, I_O = 8 * 64, I_UP = 32 * 256, I_DN = 128 * 64;
    constexpr int NITEMS = I_IN + I_OUT + 3 * I_Q + I_O + I_UP + I_DN;
    for (int it = F.gw; it < NITEMS; it += F.ngw) {
        int r = it;
        if (r < I_IN) { const int nb = r % (NPROJ / 32), kb = r / (NPROJ / 32), nd = nb * 32, ns = nd < 3072 ? nd : nd + 8;
            p0_transpose_item(A.in[12], DM, PIN, ns, (bf16*)(ws + WS_WIN), nd, nullptr, scr, kb * 64, F.lane); continue; } r -= I_IN;
        if (r < I_OUT) { const int nb = r % 64, kb = r / 64; p0_transpose_item(A.in[21], DM, DM, nb * 32, (bf16*)(ws + WS_WOUT), nb * 32, nullptr, scr, kb * 64, F.lane); continue; } r -= I_OUT;
        if (r < I_Q) { const int nb = r % 16, kb = r / 16; p0_transpose_item(A.in[25], DM, XW, nb * 32, (bf16*)(ws + WS_WQ), nb * 32, A.in[23], scr, kb * 64, F.lane); continue; } r -= I_Q;
        if (r < I_Q) { const int nb = r % 16, kb = r / 16; p0_transpose_item(A.in[26], DM, XW, nb * 32, (bf16*)(ws + WS_WKV), nb * 32, nullptr, scr, kb * 64, F.lane); continue; } r -= I_Q;
        if (r < I_Q) { const int nb = r % 16, kb = r / 16; p0_transpose_item(A.in[27], DM, XW, nb * 32, (bf16*)(ws + WS_WKV), 512 + nb * 32, nullptr, scr, kb * 64, F.lane); continue; } r -= I_Q;
        if (r < I_O) { const int nb = r % 64, kb = r / 64; p0_transpose_item(A.in[30], XW, DM, nb * 32, (bf16*)(ws + WS_WO), nb * 32, nullptr, scr, kb * 64, F.lane); continue; } r -= I_O;
        if (r < I_UP) { const int nb = r % 256, kb = r / 256; p0_transpose_item(A.in[32], DM, DFF, nb * 32, (bf16*)(ws + WS_WUP), nb * 32, A.in[31], scr, kb * 64, F.lane); continue; } r -= I_UP;
        { const int nb = r % 64, kb = r / 64; p0_transpose_item(A.in[33], DFF, DM, nb * 32, (bf16*)(ws + WS_WDN), nb * 32, nullptr, scr, kb * 64, F.lane); }
    }
    __syncthreads();
    LAS float* gwl = (LAS float*)F.lds;
    for (int e = F.tid; e < DM * 8; e += NTHR) { const int k = e >> 3, j = e & 7; gwl[e] = A.in[12][(size_t)k * PIN + 3072 + j] * A.in[11][k]; }
    __syncthreads();
    for (int m = F.gw; m < TT + BATCH * NMEM; m += F.ngw) {
        const bool ismem = m >= TT;
        const float* xrow = m < TP ? A.in[0] + (size_t)m * DM : (m < TT ? A.in[1] + (size_t)(m - TP) * DM : A.in[2] + (size_t)(m - TT) * DM);
        const float* g = ismem ? A.in[24] : A.in[11];
        bf16* orow = ismem ? (bf16*)(ws + WS_MN) + (size_t)(m - TT) * DM : (bf16*)(ws + WS_H) + (size_t)m * DM;
        const GAS f32x4* xr = (const GAS f32x4*)xrow + F.lane;
        f32x4 v[8]; float s = 0.f;
#pragma unroll
        for (int j = 0; j < 8; ++j) { v[j] = xr[64 * j]; s += (v[j].x * v[j].x + v[j].y * v[j].y) + (v[j].z * v[j].z + v[j].w * v[j].w); }
        const float rs = 1.0f / sqrtf(wave_sum(s) * (1.f / DM) + EPS);
        GAS unsigned long long* o8 = (GAS unsigned long long*)orow + F.lane;
#pragma unroll
        for (int j = 0; j < 8; ++j) { const f32x4 gg = *((const GAS f32x4*)g + F.lane + 64 * j);
            o8[64 * j] = (unsigned long long)pk2(v[j].x * rs * gg.x, v[j].y * rs * gg.y) | ((unsigned long long)pk2(v[j].z * rs * gg.z, v[j].w * rs * gg.w) << 32); }
        if (!ismem) {
            float d[8];
#pragma unroll
            for (int q = 0; q < 8; ++q) d[q] = 0.f;
#pragma unroll
            for (int j = 0; j < 8; ++j)
#pragma unroll
                for (int e = 0; e < 4; ++e) { const int k = 256 * j + 4 * F.lane + e; const f32x4 w0 = *(const LAS f32x4*)(gwl + k * 8), w1 = *(const LAS f32x4*)(gwl + k * 8 + 4); const float xv = v[j][e];
                    d[0] += xv * w0.x; d[1] += xv * w0.y; d[2] += xv * w0.z; d[3] += xv * w0.w; d[4] += xv * w1.x; d[5] += xv * w1.y; d[6] += xv * w1.z; d[7] += xv * w1.w; }
#pragma unroll
            for (int q = 0; q < 8; ++q) d[q] = wave_sum(d[q]) * rs;
            if (F.lane == 0) { float* go = (float*)(ws + WS_GATES) + (size_t)m * 8;
#pragma unroll
                for (int q = 0; q < 8; ++q) go[q] = d[q]; }
        }
    }
    __syncthreads();
}
__device__ __forceinline__ void unpack8(const v4u w, float (&x)[8]) { x[0] = bflo(w.x); x[1] = bfhi(w.x); x[2] = bflo(w.y); x[3] = bfhi(w.y); x[4] = bflo(w.z); x[5] = bfhi(w.z); x[6] = bflo(w.w); x[7] = bfhi(w.w); }
__device__ __forceinline__ void p2_prep(Frame& F, const Args& A) {
    unsigned char* ws = A.ws; float* out = A.out;
    bf16* PROJ = (bf16*)(ws + WS_PROJ); bf16* QKM = (bf16*)(ws + WS_QKM);
    const float* GATES = (const float*)(ws + WS_GATES);
    const float* convw = A.in[13]; const float* convb = A.in[14];
    const int lane = F.lane;
    for (int r = F.gw; r < TT; r += F.ngw) {
        const bool pr = r < TP; int b, t;
        if (pr) { b = r / SEQ; t = r % SEQ; } else { b = (r - TP) / DECS; t = (r - TP) % DECS; }
#pragma unroll
        for (int half = 0; half < 2; ++half) {
            const int c0 = half * 512 + 8 * lane;
            float acc[8], cur[8];
#pragma unroll
            for (int e = 0; e < 8; ++e) { acc[e] = convb[c0 + e]; cur[e] = 0.f; }
#pragma unroll
            for (int j = 0; j < 4; ++j) {
                const int tt = t - 3 + j; float xv[8];
                if (tt >= 0) { const v4u raw = *(const GAS v4u*)(PROJ + (size_t)(r - 3 + j) * NPROJ + c0); unpack8(raw, xv); }
                else if (pr) {
#pragma unroll
                    for (int e = 0; e < 8; ++e) xv[e] = 0.f; }
                else { const float* sp = A.in[3] + ((size_t)b * 3 + (3 + tt)) * 1024 + c0; const f32x4 a0 = *(const GAS f32x4*)sp, a1 = *(const GAS f32x4*)(sp + 4);
                    xv[0] = a0.x; xv[1] = a0.y; xv[2] = a0.z; xv[3] = a0.w; xv[4] = a1.x; xv[5] = a1.y; xv[6] = a1.z; xv[7] = a1.w; }
                const f32x4 w0 = *(const GAS f32x4*)(convw + j * 1024 + c0), w1 = *(const GAS f32x4*)(convw + j * 1024 + c0 + 4);
                acc[0] += w0.x * xv[0]; acc[1] += w0.y * xv[1]; acc[2] += w0.z * xv[2]; acc[3] += w0.w * xv[3];
                acc[4] += w1.x * xv[4]; acc[5] += w1.y * xv[5]; acc[6] += w1.z * xv[6]; acc[7] += w1.w * xv[7];
                if (j == 3) {
#pragma unroll
                    for (int e = 0; e < 8; ++e) cur[e] = xv[e]; }
            }
            const float sc = half ? 0.08838834764831845f : 1.0f;
#pragma unroll
            for (int e = 0; e < 8; ++e) acc[e] = acc[e] / (1.0f + expf(-acc[e])) * sc;
            v4u o; o.x = pk2(acc[0], acc[1]); o.y = pk2(acc[2], acc[3]); o.z = pk2(acc[4], acc[5]); o.w = pk2(acc[6], acc[7]);
            *(GAS v4u*)(QKM + (size_t)r * 1024 + c0) = o;
            float* cdst = nullptr;
            if (pr && t >= SEQ - 3) cdst = out + O_PCONV + ((size_t)b * 3 + (t - (SEQ - 3))) * 1024 + c0;
            if (!pr && t >= 1) cdst = out + O_SCONV + ((size_t)b * 3 + (t - 1)) * 1024 + c0;
            if (cdst) { *(GAS f32x4*)cdst = (f32x4){cur[0], cur[1], cur[2], cur[3]}; *(GAS f32x4*)(cdst + 4) = (f32x4){cur[4], cur[5], cur[6], cur[7]}; }
        }
        {
            bf16* qp = PROJ + (size_t)r * NPROJ + C_QA + 16 * lane; float x[16];
            { float a[8], c[8]; unpack8(*(const GAS v4u*)qp, a); unpack8(*(const GAS v4u*)(qp + 8), c);
#pragma unroll
              for (int e = 0; e < 8; ++e) { x[e] = a[e]; x[8 + e] = c[e]; } }
            float ss = 0.f;
#pragma unroll
            for (int e = 0; e < 16; ++e) ss += x[e] * x[e];
            ss += __shfl_xor(ss, 1); ss += __shfl_xor(ss, 2);
            const float rs = 0.125f / sqrtf(ss * (1.f / 64.f) + EPS); const float* g = A.in[18] + 16 * (lane & 3);
#pragma unroll
            for (int e = 0; e < 16; ++e) x[e] = x[e] * rs * g[e];
            v4u o0, o1; o0.x = pk2(x[0], x[1]); o0.y = pk2(x[2], x[3]); o0.z = pk2(x[4], x[5]); o0.w = pk2(x[6], x[7]);
            o1.x = pk2(x[8], x[9]); o1.y = pk2(x[10], x[11]); o1.z = pk2(x[12], x[13]); o1.w = pk2(x[14], x[15]);
            *(GAS v4u*)qp = o0; *(GAS v4u*)(qp + 8) = o1;
        }
        {
            unsigned* kp = (unsigned*)(PROJ + (size_t)r * NPROJ + C_KA + 2 * lane); const unsigned kw = *kp;
            float k0 = bflo(kw), k1 = bfhi(kw); float ss = k0 * k0 + k1 * k1;
#pragma unroll
            for (int o = 1; o < 32; o <<= 1) ss += __shfl_xor(ss, o);
            const float rs = 1.0f / sqrtf(ss * (1.f / 64.f) + EPS); const float* g = A.in[19] + 2 * (lane & 31);
            k0 = k0 * rs * g[0]; k1 = k1 * rs * g[1];
            *kp = pk2(k0, k1);
            const unsigned vw = *(const unsigned*)(PROJ + (size_t)r * NPROJ + C_VA + 2 * lane); const float v0 = bflo(vw), v1 = bfhi(vw);
            if (pr && t >= SEQ - WIN) { const size_t o = ((size_t)b * WIN + (t - (SEQ - WIN))) * 128 + 2 * lane;
                out[O_PSK + o] = k0; out[O_PSK + o + 1] = k1; out[O_PSV + o] = v0; out[O_PSV + o + 1] = v1; }
            if (!pr) { const size_t o = ((size_t)b * WIN + (WIN - DECS + t)) * 128 + 2 * lane;
                out[O_SSK + o] = k0; out[O_SSK + o + 1] = k1; out[O_SSV + o] = v0; out[O_SSV + o + 1] = v1; }
        }
    }
    { const int n4 = DECB * (WIN - DECS) * 32; const int gt = F.gw * 64 + lane, ngt = F.ngw * 64;
      for (int e = gt; e < 2 * n4; e += ngt) { const int which = e >= n4, i = which ? e - n4 : e; const int b = i / ((WIN - DECS) * 32), rem = i % ((WIN - DECS) * 32);
          const f32x4 v = *((const GAS f32x4*)(A.in[which ? 8 : 7] + ((size_t)b * WIN + DECS) * 128) + rem);
          *((GAS f32x4*)(out + (which ? O_SSV : O_SSK) + (size_t)b * WIN * 128) + rem) = v; } }
    for (int r = F.gw; r < BATCH * NMEM; r += F.ngw) {
        const float* src = (const float*)(ws + WS_MKV) + (size_t)r * 1024;
        const f32x4 a0 = *(const GAS f32x4*)(src + 8 * lane), a1 = *(const GAS f32x4*)(src + 8 * lane + 4);
        float ss = (a0.x * a0.x + a0.y * a0.y) + (a0.z * a0.z + a0.w * a0.w) + (a1.x * a1.x + a1.y * a1.y) + (a1.z * a1.z + a1.w * a1.w);
#pragma unroll
        for (int o = 1; o < 16; o <<= 1) ss += __shfl_xor(ss, o);
        const float rs = 1.0f / sqrtf(ss * (1.f / 128.f) + EPS); const float* g = A.in[29] + 8 * (lane & 15);
        const f32x4 g0 = *(const GAS f32x4*)g, g1 = *(const GAS f32x4*)(g + 4);
        float* ko = out + O_PMK + (size_t)r * 512 + 8 * lane;
        *(GAS f32x4*)ko = a0 * rs * g0; *(GAS f32x4*)(ko + 4) = a1 * rs * g1;
        float* vo = out + O_PMV + (size_t)r * 512 + 8 * lane;
        *(GAS f32x4*)vo = *(const GAS f32x4*)(src + 512 + 8 * lane); *(GAS f32x4*)(vo + 4) = *(const GAS f32x4*)(src + 512 + 8 * lane + 4);
    }
    for (int bh = F.gw; bh < BATCH * MH; bh += F.ngw) {
        const int b = bh >> 2, h = bh & 3; const float bi = A.in[15][h], bfg = A.in[16][h];
        const float* gp = GATES + ((size_t)b * SEQ + 32 * lane) * 8;
        float a = 0.f, bv = -INFINITY;
        for (int s = 0; s < 32; ++s) { const float lf = logsigmoidf(gp[s * 8 + 4 + h] + bfg), ig = gp[s * 8 + h] + bi; a += lf; bv = fmaxf(bv + lf, ig); }
        float pa = a, pb = bv;
#pragma unroll
        for (int o = 1; o < 64; o <<= 1) { const float a1 = __shfl_up(pa, o), b1 = __shfl_up(pb, o); if (lane >= o) { pb = fmaxf(b1 + pa, pb); pa = a1 + pa; } }
        float ea = __shfl_up(pa, 1), eb = __shfl_up(pb, 1); if (lane == 0) { ea = 0.f; eb = -INFINITY; }
        float bc = ea, m = fmaxf(0.f + ea, eb);
        float* gbo = (float*)(ws + WS_GB) + (size_t)bh * SEQ + 32 * lane; float* gmo = (float*)(ws + WS_GM) + (size_t)bh * SEQ + 32 * lane;
        for (int s = 0; s < 32; ++s) { const float lf = logsigmoidf(gp[s * 8 + 4 + h] + bfg), ig = gp[s * 8 + h] + bi; bc += lf; m = fmaxf(m + lf, ig); gbo[s] = bc; gmo[s] = m; }
        if (lane == 63) out[O_PM + bh] = m;
    }
}
#define WAVE_LDS_SYNC() do { asm volatile("s_waitcnt lgkmcnt(0)" ::: "memory"); __builtin_amdgcn_wave_barrier(); } while (0)
__device__ __forceinline__ int t5_bucket(int n) {
    if (n < 16) return n;
    int l = 16 + (int)(logf((float)n * (1.f / 16.f)) / 2.0794415416798357f * 16.f);
    return l < 31 ? l : 31;
}
__device__ __forceinline__ void naive_mlstm_prompt(Frame& F, const Args& A) {
    unsigned char* ws = A.ws; const int lane = F.lane;
    const bf16* PROJ = (const bf16*)(ws + WS_PROJ); const bf16* QKM = (const bf16*)(ws + WS_QKM); bf16* MIX = (bf16*)(ws + WS_MIX);
    const float* GATES = (const float*)(ws + WS_GATES); const float* GB = (const float*)(ws + WS_GB); const float* GM = (const float*)(ws + WS_GM);
    LAS float* Pw = (LAS float*)(F.lds + F.wave * 16384); LAS float* qw = Pw + 2048;
    for (int idx = F.gw; idx < BATCH * MH * SEQ; idx += F.ngw) {
        const int bh = idx / SEQ, tt = idx % SEQ, t = (bh & 1) ? SEQ - 1 - tt : tt, b = bh >> 2, h = bh & 3;
        const size_t row = (size_t)b * SEQ + t; const float bi = A.in[15][h];
        const float at = GB[bh * SEQ + t] - GM[bh * SEQ + t], em = expf(-GM[bh * SEQ + t]);
        WAVE_LDS_SYNC();
        qw[lane] = bf2f(QKM[row * 1024 + h * 128 + lane]); qw[lane + 64] = bf2f(QKM[row * 1024 + h * 128 + lane + 64]);
        WAVE_LDS_SYNC();
        float den = 0.f;
        for (int s = lane; s <= t; s += 64) {
            const size_t rs_ = (size_t)b * SEQ + s; const bf16* kr = QKM + rs_ * 1024 + 512 + h * 128; float dot = 0.f;
#pragma unroll 4
            for (int c = 0; c < 16; ++c) { float kx[8]; unpack8(*(const GAS v4u*)(kr + 8 * c), kx); const f32x4 q0 = *(const LAS f32x4*)(qw + 8 * c), q1 = *(const LAS f32x4*)(qw + 8 * c + 4);
                dot += (kx[0] * q0.x + kx[1] * q0.y) + (kx[2] * q0.z + kx[3] * q0.w) + (kx[4] * q1.x + kx[5] * q1.y) + (kx[6] * q1.z + kx[7] * q1.w); }
            const float cs = GATES[rs_ * 8 + h] + bi - GB[bh * SEQ + s];
            const float p = dot * expf(at + cs); Pw[s] = p; den += p;
        }
        den = wave_sum(den);
        WAVE_LDS_SYNC();
        float a0 = 0.f, a1 = 0.f, a2 = 0.f, a3 = 0.f;
        const bf16* vb = PROJ + (size_t)b * SEQ * NPROJ + C_VM + h * 256 + 4 * lane;
#pragma unroll 4
        for (int s = 0; s <= t; ++s) { const float p = Pw[s]; const unsigned long long vv = *(const GAS unsigned long long*)(vb + (size_t)s * NPROJ); const unsigned lo = (unsigned)vv, hi = (unsigned)(vv >> 32);
            a0 += p * bflo(lo); a1 += p * bfhi(lo); a2 += p * bflo(hi); a3 += p * bfhi(hi); }
        const float dn = 1.0f / fmaxf(fabsf(den), em);
        a0 *= dn; a1 *= dn; a2 *= dn; a3 *= dn;
        const float ss = wave_sum((a0 * a0 + a1 * a1) + (a2 * a2 + a3 * a3)); const float rn = 1.0f / sqrtf(ss * (1.f / 256.f) + EPS);
        const f32x4 g = *(const GAS f32x4*)(A.in[17] + h * 256 + 4 * lane);
        const unsigned long long ov = *(const GAS unsigned long long*)(PROJ + row * NPROJ + C_OM + h * 256 + 4 * lane); const unsigned olo = (unsigned)ov, ohi = (unsigned)(ov >> 32);
        a0 = a0 * rn * g.x * sigmoidf_(bflo(olo)); a1 = a1 * rn * g.y * sigmoidf_(bfhi(olo)); a2 = a2 * rn * g.z * sigmoidf_(bflo(ohi)); a3 = a3 * rn * g.w * sigmoidf_(bfhi(ohi));
        *(GAS unsigned long long*)(MIX + row * DM + h * 256 + 4 * lane) = (unsigned long long)pk2(a0, a1) | ((unsigned long long)pk2(a2, a3) << 32);
    }
}
__device__ __forceinline__ void naive_mlstm_prompt_state(Frame& F, const Args& A) {
    unsigned char* ws = A.ws; const int lane = F.lane; float* out = A.out;
    const bf16* PROJ = (const bf16*)(ws + WS_PROJ); const bf16* QKM = (const bf16*)(ws + WS_QKM);
    const float* GATES = (const float*)(ws + WS_GATES); const float* GB = (const float*)(ws + WS_GB); const float* GM = (const float*)(ws + WS_GM);
    for (int idx = F.gw; idx < BATCH * MH * MDK; idx += F.ngw) {
        const int bh = idx / MDK, dk = idx % MDK, b = bh >> 2, h = bh & 3; const float bi = A.in[15][h];
        const float base = GB[bh * SEQ + SEQ - 1] - GM[bh * SEQ + SEQ - 1];
        float a0 = 0.f, a1 = 0.f, a2 = 0.f, a3 = 0.f, na = 0.f;
        const bf16* vb = PROJ + (size_t)b * SEQ * NPROJ + C_VM + h * 256 + 4 * lane;
#pragma unroll 4
        for (int s = 0; s < SEQ; ++s) { const size_t rs_ = (size_t)b * SEQ + s;
            const float w = expf(base - GB[bh * SEQ + s] + GATES[rs_ * 8 + h] + bi) * bf2f(QKM[rs_ * 1024 + 512 + h * 128 + dk]);
            const unsigned long long vv = *(const GAS unsigned long long*)(vb + (size_t)s * NPROJ); const unsigned lo = (unsigned)vv, hi = (unsigned)(vv >> 32);
            a0 += w * bflo(lo); a1 += w * bfhi(lo); a2 += w * bflo(hi); a3 += w * bfhi(hi); na += w; }
        *(GAS f32x4*)(out + O_PC + ((size_t)bh * MDK + dk) * MDV + 4 * lane) = (f32x4){a0, a1, a2, a3};
        if (lane == 0) out[O_PN + bh * MDK + dk] = na;
    }
}
__device__ __forceinline__ void naive_mlstm_sample(Frame& F, const Args& A) {
    unsigned char* ws = A.ws; const int lane = F.lane; float* out = A.out;
    const bf16* PROJ = (const bf16*)(ws + WS_PROJ); const bf16* QKM = (const bf16*)(ws + WS_QKM); bf16* MIX = (bf16*)(ws + WS_MIX);
    const float* GATES = (const float*)(ws + WS_GATES);
    LAS float* qs = (LAS float*)(F.lds + F.wave * 16384); LAS float* ks = qs + 512;
    for (int idx = F.gw; idx < DECB * MH; idx += F.ngw) {
        const int b = idx >> 2, h = idx & 3; const size_t r0 = (size_t)TP + 4 * b;
        const float bi = A.in[15][h], bfg = A.in[16][h], m0 = A.in[6][idx];
        float ig[4], bc[4], mt[4]; { float c = 0.f;
#pragma unroll
            for (int i = 0; i < 4; ++i) { ig[i] = GATES[(r0 + i) * 8 + h] + bi; c += logsigmoidf(GATES[(r0 + i) * 8 + 4 + h] + bfg); bc[i] = c; } }
#pragma unroll
        for (int i = 0; i < 4; ++i) { float m = bc[i] + m0;
#pragma unroll
            for (int s = 0; s <= i; ++s) m = fmaxf(m, bc[i] - bc[s] + ig[s]);
            mt[i] = m; }
        WAVE_LDS_SYNC();
#pragma unroll
        for (int i = 0; i < 4; ++i) { qs[i * 128 + lane] = bf2f(QKM[(r0 + i) * 1024 + h * 128 + lane]); qs[i * 128 + lane + 64] = bf2f(QKM[(r0 + i) * 1024 + h * 128 + lane + 64]);
            ks[i * 128 + lane] = bf2f(QKM[(r0 + i) * 1024 + 512 + h * 128 + lane]); ks[i * 128 + lane + 64] = bf2f(QKM[(r0 + i) * 1024 + 512 + h * 128 + lane + 64]); }
        WAVE_LDS_SYNC();
        const float* n0p = A.in[5] + (size_t)idx * MDK; const float n0a = n0p[lane], n0b = n0p[lane + 64];
        float S[4][4], qn[4];
#pragma unroll
        for (int i = 0; i < 4; ++i) { qn[i] = wave_sum(qs[i * 128 + lane] * n0a + qs[i * 128 + lane + 64] * n0b);
#pragma unroll
            for (int s = 0; s < 4; ++s) { S[i][s] = 0.f; if (s <= i) S[i][s] = wave_sum(qs[i * 128 + lane] * ks[s * 128 + lane] + qs[i * 128 + lane + 64] * ks[s * 128 + lane + 64]) * expf(bc[i] - bc[s] + ig[s] - mt[i]); } }
        const float mnew = mt[3], decay = expf(bc[3] + m0 - mnew); float wst[4];
#pragma unroll
        for (int s = 0; s < 4; ++s) wst[s] = expf(bc[3] - bc[s] + ig[s] - mnew);
        f32x4 v[4], qc[4];
#pragma unroll
        for (int i = 0; i < 4; ++i) { const unsigned long long vv = *(const GAS unsigned long long*)(PROJ + (r0 + i) * NPROJ + C_VM + h * 256 + 4 * lane); const unsigned lo = (unsigned)vv, hi = (unsigned)(vv >> 32);
            v[i] = (f32x4){bflo(lo), bfhi(lo), bflo(hi), bfhi(hi)}; qc[i] = (f32x4){0.f, 0.f, 0.f, 0.f}; }
        const float* c0p = A.in[4] + (size_t)idx * MDK * MDV + 4 * lane; float* cnp = out + O_SC + (size_t)idx * MDK * MDV + 4 * lane;
#pragma unroll 4
        for (int dk = 0; dk < MDK; ++dk) { const f32x4 c0 = *(const GAS f32x4*)(c0p + (size_t)dk * MDV);
            f32x4 cn = c0 * decay;
#pragma unroll
            for (int i = 0; i < 4; ++i) { qc[i] += c0 * qs[i * 128 + dk]; cn += v[i] * (ks[i * 128 + dk] * wst[i]); }
            *(GAS f32x4*)(cnp + (size_t)dk * MDV) = cn; }
        { float na = decay * n0a, nb = decay * n0b;
#pragma unroll
          for (int s = 0; s < 4; ++s) { na += ks[s * 128 + lane] * wst[s]; nb += ks[s * 128 + lane + 64] * wst[s]; }
          out[O_SN + (size_t)idx * MDK + lane] = na; out[O_SN + (size_t)idx * MDK + lane + 64] = nb; if (lane == 0) out[O_SM + idx] = mnew; }
        const f32x4 g = *(const GAS f32x4*)(A.in[17] + h * 256 + 4 * lane);
#pragma unroll
        for (int i = 0; i < 4; ++i) { const float wi = expf(bc[i] + m0 - mt[i]); f32x4 num = qc[i] * wi; float den = wi * qn[i];
#pragma unroll
            for (int s = 0; s < 4; ++s) { num += v[s] * S[i][s]; den += S[i][s]; }
            num = num * (1.0f / fmaxf(fabsf(den), expf(-mt[i])));
            const float ss = wave_sum((num.x * num.x + num.y * num.y) + (num.z * num.z + num.w * num.w)); const float rn = 1.0f / sqrtf(ss * (1.f / 256.f) + EPS);
            const unsigned long long ov = *(const GAS unsigned long long*)(PROJ + (r0 + i) * NPROJ + C_OM + h * 256 + 4 * lane); const unsigned olo = (unsigned)ov, ohi = (unsigned)(ov >> 32);
            const float o0 = num.x * rn * g.x * sigmoidf_(bflo(olo)), o1 = num.y * rn * g.y * sigmoidf_(bfhi(olo)), o2 = num.z * rn * g.z * sigmoidf_(bflo(ohi)), o3 = num.w * rn * g.w * sigmoidf_(bfhi(ohi));
            *(GAS unsigned long long*)(MIX + (r0 + i) * DM + h * 256 + 4 * lane) = (unsigned long long)pk2(o0, o1) | ((unsigned long long)pk2(o2, o3) << 32); }
    }
}
__device__ __forceinline__ void naive_swa(Frame& F, const Args& A) {
    unsigned char* ws = A.ws; const int lane = F.lane;
    const bf16* PROJ = (const bf16*)(ws + WS_PROJ); bf16* MIX = (bf16*)(ws + WS_MIX);
    LAS float* Pw = (LAS float*)(F.lds + F.wave * 16384); LAS float* qw = Pw + 256;
    for (int idx = F.gw; idx < TT * AH; idx += F.ngw) {
        const int head = idx & 15, r = idx >> 4, kvh = head >> 3; const bool pr = r < TP;
        int b, t; if (pr) { b = r / SEQ; t = r % SEQ; } else { b = (r - TP) / DECS; t = (r - TP) % DECS; }
        WAVE_LDS_SYNC();
        qw[lane] = bf2f(PROJ[(size_t)r * NPROJ + C_QA + head * 64 + lane]);
        WAVE_LDS_SYNC();
        const float sink = A.in[20][head];
        float sc[2]; bool vl[2];
#pragma unroll
        for (int jj = 0; jj < 2; ++jj) {
            const int j = lane + 64 * jj, dist = 127 - j;
            float dot = 0.f; bool valid;
            if (pr) { const int pos = t - dist; valid = pos >= 0;
                if (valid) { const bf16* kr = PROJ + ((size_t)b * SEQ + pos) * NPROJ + C_KA + kvh * 64;
#pragma unroll
                    for (int c = 0; c < 8; ++c) { float kx[8]; unpack8(*(const GAS v4u*)(kr + 8 * c), kx); const f32x4 q0 = *(const LAS f32x4*)(qw + 8 * c), q1 = *(const LAS f32x4*)(qw + 8 * c + 4);
                        dot += (kx[0] * q0.x + kx[1] * q0.y) + (kx[2] * q0.z + kx[3] * q0.w) + (kx[4] * q1.x + kx[5] * q1.y) + (kx[6] * q1.z + kx[7] * q1.w); } } }
            else { valid = true; const int kb = WIN + t - dist;
                if (kb < WIN) { const float* kr = A.in[7] + ((size_t)b * WIN + kb) * 128 + kvh * 64;
#pragma unroll
                    for (int c = 0; c < 16; ++c) { const f32x4 kx = *(const GAS f32x4*)(kr + 4 * c), q0 = *(const LAS f32x4*)(qw + 4 * c); dot += (kx.x * q0.x + kx.y * q0.y) + (kx.z * q0.z + kx.w * q0.w); } }
                else { const bf16* kr = PROJ + ((size_t)TP + 4 * b + (kb - WIN)) * NPROJ + C_KA + kvh * 64;
#pragma unroll
                    for (int c = 0; c < 8; ++c) { float kx[8]; unpack8(*(const GAS v4u*)(kr + 8 * c), kx); const f32x4 q0 = *(const LAS f32x4*)(qw + 8 * c), q1 = *(const LAS f32x4*)(qw + 8 * c + 4);
                        dot += (kx[0] * q0.x + kx[1] * q0.y) + (kx[2] * q0.z + kx[3] * q0.w) + (kx[4] * q1.x + kx[5] * q1.y) + (kx[6] * q1.z + kx[7] * q1.w); } } }
            sc[jj] = dot + A.in[22][t5_bucket(dist) * 16 + head]; vl[jj] = valid;
        }
        float m = fmaxf(vl[0] ? sc[0] : -1e30f, vl[1] ? sc[1] : -1e30f); m = fmaxf(wave_max(m), sink);
        const float p0 = vl[0] ? expf(sc[0] - m) : 0.f, p1 = vl[1] ? expf(sc[1] - m) : 0.f;
        const float l = wave_sum(p0 + p1) + expf(sink - m), il = 1.0f / l;
        Pw[lane] = p0 * il; Pw[lane + 64] = p1 * il;
        WAVE_LDS_SYNC();
        float acc = 0.f;
        if (pr) { const int j0 = t >= 127 ? 0 : 127 - t;
            for (int j = j0; j < 128; ++j) acc += Pw[j] * bf2f(PROJ[((size_t)b * SEQ + (t - 127 + j)) * NPROJ + C_VA + kvh * 64 + lane]); }
        else { for (int j = 0; j < 128; ++j) { const int kb = WIN + t - (127 - j);
                const float vv = kb < WIN ? A.in[8][((size_t)b * WIN + kb) * 128 + kvh * 64 + lane] : bf2f(PROJ[((size_t)TP + 4 * b + (kb - WIN)) * NPROJ + C_VA + kvh * 64 + lane]);
                acc += Pw[j] * vv; } }
        MIX[(size_t)r * DM + 1024 + head * 64 + lane] = (bf16)f2bf(acc);
    }
}
__device__ __forceinline__ void naive_xattn(Frame& F, const Args& A) {
    unsigned char* ws = A.ws; const int lane = F.lane;
    const bf16* QX = (const bf16*)(ws + WS_QX); bf16* OX = (bf16*)(ws + WS_OX);
    LAS float* Pw = (LAS float*)(F.lds + F.wave * 16384); LAS float* qw = Pw + 256;
    for (int idx = F.gw; idx < TT * XH; idx += F.ngw) {
        const int head = idx & 3, r = idx >> 2; const bool pr = r < TP; const int b = pr ? r / SEQ : (r - TP) / DECS;
        const float* Kb = (pr ? A.out + O_PMK : A.in[9]) + (size_t)b * NMEM * XW + head * XHD;
        const float* Vb = (pr ? A.out + O_PMV : A.in[10]) + (size_t)b * NMEM * XW + head * XHD;
        const float q0 = bf2f(QX[(size_t)r * XW + head * XHD + lane]), q1 = bf2f(QX[(size_t)r * XW + head * XHD + lane + 64]);
        const float rs = 0.08838834764831845f / sqrtf(wave_sum(q0 * q0 + q1 * q1) * (1.f / 128.f) + EPS);
        WAVE_LDS_SYNC();
        qw[lane] = q0 * rs * A.in[28][lane]; qw[lane + 64] = q1 * rs * A.in[28][lane + 64];
        WAVE_LDS_SYNC();
        float sc[4];
#pragma unroll
        for (int jj = 0; jj < 4; ++jj) { const float* kr = Kb + (size_t)(lane + 64 * jj) * XW; float dot = 0.f;
#pragma unroll 8
            for (int c = 0; c < 32; ++c) { const f32x4 kx = *(const GAS f32x4*)(kr + 4 * c), qq = *(const LAS f32x4*)(qw + 4 * c); dot += (kx.x * qq.x + kx.y * qq.y) + (kx.z * qq.z + kx.w * qq.w); }
            sc[jj] = dot; }
        const float m = wave_max(fmaxf(fmaxf(sc[0], sc[1]), fmaxf(sc[2], sc[3])));
        float p[4], ls = 0.f;
#pragma unroll
        for (int jj = 0; jj < 4; ++jj) { p[jj] = expf(sc[jj] - m); ls += p[jj]; }
        const float il = 1.0f / wave_sum(ls);
#pragma unroll
        for (int jj = 0; jj < 4; ++jj) Pw[lane + 64 * jj] = p[jj] * il;
        WAVE_LDS_SYNC();
        float a0 = 0.f, a1 = 0.f;
#pragma unroll 4
        for (int j = 0; j < NMEM; ++j) { const float pj = Pw[j]; a0 += pj * Vb[(size_t)j * XW + lane]; a1 += pj * Vb[(size_t)j * XW + lane + 64]; }
        OX[(size_t)r * XW + head * XHD + lane] = (bf16)f2bf(a0); OX[(size_t)r * XW + head * XHD + lane + 64] = (bf16)f2bf(a1);
    }
}
typedef short s16x4 __attribute__((ext_vector_type(4)));
typedef short v4i16_t __attribute__((ext_vector_type(4)));
__device__ __forceinline__ s16x4 ldtr(LAS const unsigned char* p) { return __builtin_bit_cast(s16x4, __builtin_amdgcn_ds_read_tr16_b64_v4i16((LAS v4i16_t*)p)); }
__device__ __forceinline__ bf16x8 mk8(s16x4 lo, s16x4 hi) { return (bf16x8){lo[0], lo[1], lo[2], lo[3], hi[0], hi[1], hi[2], hi[3]}; }
__device__ __forceinline__ bf16x8 pack8(const float (&p)[8]) { v4u w; w.x = pk2(p[0], p[1]); w.y = pk2(p[2], p[3]); w.z = pk2(p[4], p[5]); w.w = pk2(p[6], p[7]); return __builtin_bit_cast(bf16x8, w); }
constexpr int ML_KS = 272, ML_VS = 528;
constexpr int ML_K = 0, ML_V = 128 * ML_KS, ML_KW = ML_V + 128 * ML_VS, ML_CS = ML_KW + 128 * ML_KS, ML_RED = ML_CS + 512, ML_END = ML_RED + 1024;
static_assert(ML_END <= RING_BYTES, "mlstm LDS");
__device__ __forceinline__ void mlstm_prompt_unit(Frame& F, const Args& A, int bh, int qb) {
    unsigned char* ws = A.ws; const int lane = F.lane, tid = F.tid, w = F.wave, qg = w & 3, dh = w >> 2, g = lane >> 4, c16 = lane & 15;
    const int b = bh >> 2, h = bh & 3; const size_t rowb = (size_t)b * SEQ;
    const bf16* PROJ = (const bf16*)(ws + WS_PROJ); const bf16* QKM = (const bf16*)(ws + WS_QKM); bf16* MIX = (bf16*)(ws + WS_MIX);
    const float* GATES = (const float*)(ws + WS_GATES); const float* GB = (const float*)(ws + WS_GB) + (size_t)bh * SEQ; const float* GM = (const float*)(ws + WS_GM) + (size_t)bh * SEQ;
    LAS unsigned char* L = F.lds;
    const float bi = A.in[15][h], blast = GB[SEQ - 1], mlast = GM[SEQ - 1];
    bf16x8 qf[2][4]; float a2[2], em[2];
#pragma unroll
    for (int u = 0; u < 2; ++u) { const int t = 128 * qb + 32 * qg + 16 * u + c16; const bf16* qp = QKM + (rowb + t) * 1024 + h * 128 + 8 * g;
#pragma unroll
        for (int ds = 0; ds < 4; ++ds) qf[u][ds] = *(const GAS bf16x8*)(qp + 32 * ds);
        a2[u] = (GB[t] - GM[t]) * LOG2E; em[u] = expf(-GM[t]); }
    f32x4 o[2][8]; float den[2] = {0.f, 0.f};
#pragma unroll
    for (int u = 0; u < 2; ++u)
#pragma unroll
        for (int dt = 0; dt < 8; ++dt) o[u][dt] = (f32x4){0.f, 0.f, 0.f, 0.f};
    for (int kb = 0; kb <= qb; ++kb) {
        const bool last = kb == qb;
        __syncthreads();
#pragma unroll
        for (int j = 0; j < 4; ++j) { const int id = tid + NTHR * j, row = id >> 4, ch = id & 15, s = 128 * kb + row;
            const v4u v = *(const GAS v4u*)(QKM + (rowb + s) * 1024 + 512 + h * 128 + 8 * ch);
            *(LAS v4u*)(L + ML_K + row * ML_KS + ch * 16) = v;
            if (last) { const float wf = expf(blast - GB[s] + GATES[(rowb + s) * 8 + h] + bi - mlast); float x[8]; unpack8(v, x);
#pragma unroll
                for (int e = 0; e < 8; ++e) x[e] *= wf;
                v4u o2; o2.x = pk2(x[0], x[1]); o2.y = pk2(x[2], x[3]); o2.z = pk2(x[4], x[5]); o2.w = pk2(x[6], x[7]);
                *(LAS v4u*)(L + ML_KW + row * ML_KS + ch * 16) = o2; } }
#pragma unroll
        for (int j = 0; j < 8; ++j) { const int id = tid + NTHR * j, row = id >> 5, ch = id & 31, s = 128 * kb + row;
            *(LAS v4u*)(L + ML_V + row * ML_VS + ch * 16) = *(const GAS v4u*)(PROJ + (rowb + s) * NPROJ + C_VM + h * 256 + 8 * ch); }
        if (tid < 128) { const int s = 128 * kb + tid; ((LAS float*)(L + ML_CS))[tid] = (GATES[(rowb + s) * 8 + h] + bi - GB[s]) * LOG2E; }
        __syncthreads();
        for (int ks = 0; ks < 4; ++ks) {
            if (last && ks > qg) break;
            f32x4 sa[2][2];
#pragma unroll
            for (int u = 0; u < 2; ++u)
#pragma unroll
                for (int kt = 0; kt < 2; ++kt) sa[u][kt] = (f32x4){0.f, 0.f, 0.f, 0.f};
#pragma unroll
            for (int ds = 0; ds < 4; ++ds)
#pragma unroll
                for (int kt = 0; kt < 2; ++kt) { const bf16x8 kf = *(const LAS bf16x8*)(L + ML_K + (32 * ks + 16 * kt + c16) * ML_KS + (32 * ds + 8 * g) * 2);
#pragma unroll
                    for (int u = 0; u < 2; ++u) sa[u][kt] = __builtin_amdgcn_mfma_f32_16x16x32_bf16(kf, qf[u][ds], sa[u][kt], 0, 0, 0); }
            float pv[2][8];
#pragma unroll
            for (int kt = 0; kt < 2; ++kt) { const f32x4 c4 = *(const LAS f32x4*)(L + ML_CS + (32 * ks + 16 * kt + 4 * g) * 4);
#pragma unroll
                for (int u = 0; u < 2; ++u)
#pragma unroll
                    for (int r = 0; r < 4; ++r) { const int kk = 32 * ks + 16 * kt + 4 * g + r, ql = 32 * qg + 16 * u + c16;
                        float p = sa[u][kt][r] * __builtin_amdgcn_exp2f(a2[u] + c4[r]); if (last && kk > ql) p = 0.f;
                        den[u] += p; pv[u][kt * 4 + r] = p; } }
            const bf16x8 pf0 = pack8(pv[0]), pf1 = pack8(pv[1]);
#pragma unroll
            for (int dt = 0; dt < 8; ++dt) { LAS const unsigned char* vp = L + ML_V + (32 * ks + 4 * g + (c16 >> 2)) * ML_VS + (128 * dh + 16 * dt + 4 * (lane & 3)) * 2;
                const bf16x8 vf = mk8(ldtr(vp), ldtr(vp + 16 * ML_VS));
                o[0][dt] = __builtin_amdgcn_mfma_f32_16x16x32_bf16(vf, pf0, o[0][dt], 0, 0, 0);
                o[1][dt] = __builtin_amdgcn_mfma_f32_16x16x32_bf16(vf, pf1, o[1][dt], 0, 0, 0); }
        }
    }
    float rn[2], dn[2];
#pragma unroll
    for (int u = 0; u < 2; ++u) { float d = den[u]; d += __shfl_xor(d, 16); d += __shfl_xor(d, 32); dn[u] = 1.0f / fmaxf(fabsf(d), em[u]);
        float ss = 0.f;
#pragma unroll
        for (int dt = 0; dt < 8; ++dt) { o[u][dt] = o[u][dt] * dn[u]; ss += (o[u][dt][0] * o[u][dt][0] + o[u][dt][1] * o[u][dt][1]) + (o[u][dt][2] * o[u][dt][2] + o[u][dt][3] * o[u][dt][3]); }
        ss += __shfl_xor(ss, 16); ss += __shfl_xor(ss, 32);
        if (g == 0) ((LAS float*)(L + ML_RED))[(w * 2 + u) * 16 + c16] = ss; }
    __syncthreads();
#pragma unroll
    for (int u = 0; u < 2; ++u) { const float tot = ((LAS float*)(L + ML_RED))[(w * 2 + u) * 16 + c16] + ((LAS float*)(L + ML_RED))[((w ^ 4) * 2 + u) * 16 + c16];
        rn[u] = 1.0f / sqrtf(tot * (1.f / 256.f) + EPS); }
#pragma unroll
    for (int u = 0; u < 2; ++u) { const int t = 128 * qb + 32 * qg + 16 * u + c16;
#pragma unroll
        for (int dt = 0; dt < 8; ++dt) { const int dv0 = 128 * dh + 16 * dt + 4 * g;
            const unsigned long long ov = *(const GAS unsigned long long*)(PROJ + (rowb + t) * NPROJ + C_OM + h * 256 + dv0); const unsigned olo = (unsigned)ov, ohi = (unsigned)(ov >> 32);
            const f32x4 gn = *(const GAS f32x4*)(A.in[17] + h * 256 + dv0);
            const float v0 = o[u][dt][0] * rn[u] * gn.x * sigmoidf_(bflo(olo)), v1 = o[u][dt][1] * rn[u] * gn.y * sigmoidf_(bfhi(olo)), v2 = o[u][dt][2] * rn[u] * gn.z * sigmoidf_(bflo(ohi)), v3 = o[u][dt][3] * rn[u] * gn.w * sigmoidf_(bfhi(ohi));
            *(GAS unsigned long long*)(MIX + (rowb + t) * DM + h * 256 + dv0) = (unsigned long long)pk2(v0, v1) | ((unsigned long long)pk2(v2, v3) << 32); } }
    {
        f32x4 uu[16];
#pragma unroll
        for (int dt = 0; dt < 16; ++dt) uu[dt] = (f32x4){0.f, 0.f, 0.f, 0.f};
#pragma unroll
        for (int ss = 0; ss < 4; ++ss) { LAS const unsigned char* ap = L + ML_KW + (32 * ss + 8 * g + (c16 >> 2)) * ML_KS + (16 * w + 4 * (lane & 3)) * 2;
            const bf16x8 af = mk8(ldtr(ap), ldtr(ap + 4 * ML_KS));
#pragma unroll
            for (int dt = 0; dt < 16; ++dt) { LAS const unsigned char* bp = L + ML_V + (32 * ss + 8 * g + (c16 >> 2)) * ML_VS + (16 * dt + 4 * (lane & 3)) * 2;
                const bf16x8 bfr = mk8(ldtr(bp), ldtr(bp + 4 * ML_VS));
                uu[dt] = __builtin_amdgcn_mfma_f32_16x16x32_bf16(af, bfr, uu[dt], 0, 0, 0); } }
        float* slab = (float*)(ws + WS_SLAB) + ((size_t)bh * 16 + qb) * (MDK * MDV);
#pragma unroll
        for (int dt = 0; dt < 16; ++dt)
#pragma unroll
            for (int r = 0; r < 4; ++r) slab[(16 * w + 4 * g + r) * MDV + 16 * dt + c16] = uu[dt][r];
        if (tid < 128) { float s = 0.f; for (int i = 0; i < 128; ++i) s += bf2f(*(const LAS unsigned short*)(L + ML_KW + i * ML_KS + tid * 2));
            ((float*)(ws + WS_UN))[((size_t)bh * 16 + qb) * MDK + tid] = s; }
    }
}
__device__ __forceinline__ void mlstm_prompt_phase(Frame& F, const Args& A) {
    for (int u = F.vcu; u < BATCH * MH * 16; u += F.G) mlstm_prompt_unit(F, A, u >> 4, 15 - (u & 15));
    __syncthreads();
}
__device__ __forceinline__ void mlstm_state_combine(Frame& F, const Args& A) {
    const float* slab = (const float*)(A.ws + WS_SLAB); const float* un = (const float*)(A.ws + WS_UN);
    const int gt = F.gw * 64 + F.lane, ngt = F.ngw * 64;
    for (int e = gt; e < BATCH * MH * MDK * MDV / 4; e += ngt) { const int bh = e / (MDK * MDV / 4), r = e % (MDK * MDV / 4); f32x4 s = (f32x4){0.f, 0.f, 0.f, 0.f};
#pragma unroll
        for (int q = 0; q < 16; ++q) s += *((const GAS f32x4*)(slab + ((size_t)bh * 16 + q) * (MDK * MDV)) + r);
        *((GAS f32x4*)(A.out + O_PC) + e) = s; }
    for (int e = gt; e < BATCH * MH * MDK; e += ngt) { const int bh = e / MDK, r = e % MDK; float s = 0.f;
#pragma unroll
        for (int q = 0; q < 16; ++q) s += un[((size_t)bh * 16 + q) * MDK + r];
        A.out[O_PN + e] = s; }
}
constexpr int XA_S = 272, XA_K = 0, XA_V = 256 * XA_S, XA_END = 2 * 256 * XA_S;
static_assert(XA_END <= RING_BYTES, "xattn LDS");
__device__ __forceinline__ void xattn_unit(Frame& F, const Args& A, const float* Kb, const float* Vb, int head, size_t row0, int nq) {
    const int lane = F.lane, tid = F.tid, w = F.wave, g = lane >> 4, c16 = lane & 15;
    LAS unsigned char* L = F.lds;
    const bf16* QX = (const bf16*)(A.ws + WS_QX); bf16* OX = (bf16*)(A.ws + WS_OX);
    __syncthreads();
#pragma unroll
    for (int half = 0; half < 2; ++half) { const float* src = half ? Vb : Kb; const int base = half ? XA_V : XA_K;
#pragma unroll 8
        for (int j = 0; j < 16; ++j) { const int id = tid + NTHR * j, row = id >> 5, c4 = id & 31;
            const f32x4 f = *(const GAS f32x4*)(src + (size_t)row * XW + 4 * c4);
            *(LAS unsigned long long*)(L + base + row * XA_S + c4 * 8) = (unsigned long long)pk2(f.x, f.y) | ((unsigned long long)pk2(f.z, f.w) << 32); } }
    __syncthreads();
    if (16 * w >= nq) return;
    const int qi = 16 * w + c16; const bool valid = qi < nq; const size_t row = row0 + (valid ? qi : 0);
    bf16x8 qf[4];
    { float x[4][8]; float ss = 0.f;
#pragma unroll
      for (int ds = 0; ds < 4; ++ds) { unpack8(*(const GAS v4u*)(QX + row * XW + head * XHD + 32 * ds + 8 * g), x[ds]);
#pragma unroll
          for (int e = 0; e < 8; ++e) ss += x[ds][e] * x[ds][e]; }
      ss += __shfl_xor(ss, 16); ss += __shfl_xor(ss, 32);
      const float rs = (0.08838834764831845f * LOG2E) / sqrtf(ss * (1.f / 128.f) + EPS);
#pragma unroll
      for (int ds = 0; ds < 4; ++ds) { const float* gp = A.in[28] + 32 * ds + 8 * g; float y[8];
#pragma unroll
          for (int e = 0; e < 8; ++e) y[e] = x[ds][e] * rs * gp[e];
          qf[ds] = pack8(y); } }
    f32x4 sa[16];
#pragma unroll
    for (int kt = 0; kt < 16; ++kt) { sa[kt] = (f32x4){0.f, 0.f, 0.f, 0.f};
#pragma unroll
        for (int ds = 0; ds < 4; ++ds) { const bf16x8 kf = *(const LAS bf16x8*)(L + XA_K + (16 * kt + c16) * XA_S + (32 * ds + 8 * g) * 2);
            sa[kt] = __builtin_amdgcn_mfma_f32_16x16x32_bf16(kf, qf[ds], sa[kt], 0, 0, 0); } }
    float m = -INFINITY;
#pragma unroll
    for (int kt = 0; kt < 16; ++kt) m = fmaxf(m, fmaxf(fmaxf(sa[kt][0], sa[kt][1]), fmaxf(sa[kt][2], sa[kt][3])));
    m = fmaxf(m, __shfl_xor(m, 16)); m = fmaxf(m, __shfl_xor(m, 32));
    f32x4 o[8]; float l = 0.f;
#pragma unroll
    for (int dt = 0; dt < 8; ++dt) o[dt] = (f32x4){0.f, 0.f, 0.f, 0.f};
#pragma unroll
    for (int ks = 0; ks < 8; ++ks) { float pv[8];
#pragma unroll
        for (int k2 = 0; k2 < 2; ++k2)
#pragma unroll
            for (int r = 0; r < 4; ++r) { const float p = __builtin_amdgcn_exp2f(sa[2 * ks + k2][r] - m); l += p; pv[k2 * 4 + r] = p; }
        const bf16x8 pf = pack8(pv);
#pragma unroll
        for (int dt = 0; dt < 8; ++dt) { LAS const unsigned char* vp = L + XA_V + (32 * ks + 4 * g + (c16 >> 2)) * XA_S + (16 * dt + 4 * (lane & 3)) * 2;
            const bf16x8 vf = mk8(ldtr(vp), ldtr(vp + 16 * XA_S));
            o[dt] = __builtin_amdgcn_mfma_f32_16x16x32_bf16(vf, pf, o[dt], 0, 0, 0); } }
    l += __shfl_xor(l, 16); l += __shfl_xor(l, 32);
    const float il = 1.0f / l;
    if (valid) {
#pragma unroll
        for (int dt = 0; dt < 8; ++dt) *(GAS unsigned long long*)(OX + row * XW + head * XHD + 16 * dt + 4 * g) = (unsigned long long)pk2(o[dt][0] * il, o[dt][1] * il) | ((unsigned long long)pk2(o[dt][2] * il, o[dt][3] * il) << 32); }
}
__device__ __forceinline__ void xattn_phase(Frame& F, const Args& A) {
    for (int u = F.vcu; u < 256 + DECB * XH; u += F.G) {
        if (u < 256) { const int b = u >> 6, head = (u >> 4) & 3, qb = u & 15;
            xattn_unit(F, A, A.out + O_PMK + (size_t)b * NMEM * XW + head * XHD, A.out + O_PMV + (size_t)b * NMEM * XW + head * XHD, head, (size_t)b * SEQ + 128 * qb, 128); }
        else { const int su = u - 256, b = su >> 2, head = su & 3;
            xattn_unit(F, A, A.in[9] + (size_t)b * NMEM * XW + head * XHD, A.in[10] + (size_t)b * NMEM * XW + head * XHD, head, (size_t)TP + 4 * b, 4); }
    }
    __syncthreads();
}
constexpr int SW_S = 144;
__device__ __forceinline__ void swa_core(LAS const unsigned char* Kt, LAS const unsigned char* Vt, LAS const float* tbl  , const bf16x8 (&qf)[2], int distbase, int kkmin, float sink2,
                                         bf16* orow  , int lane) {
    const int g = lane >> 4, c16 = lane & 15;
    f32x4 sa[10]; float m = sink2;
#pragma unroll
    for (int i = 0; i < 10; ++i) { sa[i] = (f32x4){0.f, 0.f, 0.f, 0.f};
#pragma unroll
        for (int ds = 0; ds < 2; ++ds) { const bf16x8 kf = *(const LAS bf16x8*)(Kt + (16 * i + c16) * SW_S + (32 * ds + 8 * g) * 2);
            sa[i] = __builtin_amdgcn_mfma_f32_16x16x32_bf16(kf, qf[ds], sa[i], 0, 0, 0); }
#pragma unroll
        for (int r = 0; r < 4; ++r) { const int dist = distbase - 16 * i - 4 * g - r, kk = 16 * i + 4 * g + r; const bool ok = dist >= 0 && dist < WIN && kk >= kkmin;
            const float s = ok ? sa[i][r] * LOG2E + tbl[ok ? dist : 0] : -INFINITY; sa[i][r] = s; m = fmaxf(m, s); } }
    m = fmaxf(m, __shfl_xor(m, 16)); m = fmaxf(m, __shfl_xor(m, 32));
    f32x4 o[4]; float l = 0.f;
#pragma unroll
    for (int dt = 0; dt < 4; ++dt) o[dt] = (f32x4){0.f, 0.f, 0.f, 0.f};
#pragma unroll
    for (int j = 0; j < 5; ++j) { float pv[8];
#pragma unroll
        for (int k2 = 0; k2 < 2; ++k2)
#pragma unroll
            for (int r = 0; r < 4; ++r) { const float p = __builtin_amdgcn_exp2f(sa[2 * j + k2][r] - m); l += p; pv[k2 * 4 + r] = p; }
        const bf16x8 pf = pack8(pv);
#pragma unroll
        for (int dt = 0; dt < 4; ++dt) { LAS const unsigned char* vp = Vt + (32 * j + 4 * g + (c16 >> 2)) * SW_S + (16 * dt + 4 * (lane & 3)) * 2;
            const bf16x8 vf = mk8(ldtr(vp), ldtr(vp + 16 * SW_S));
            o[dt] = __builtin_amdgcn_mfma_f32_16x16x32_bf16(vf, pf, o[dt], 0, 0, 0); } }
    l += __shfl_xor(l, 16); l += __shfl_xor(l, 32);
    const float il = 1.0f / (l + __builtin_amdgcn_exp2f(sink2 - m));
    if (orow) {
#pragma unroll
        for (int dt = 0; dt < 4; ++dt) *(GAS unsigned long long*)(orow + 16 * dt + 4 * g) = (unsigned long long)pk2(o[dt][0] * il, o[dt][1] * il) | ((unsigned long long)pk2(o[dt][2] * il, o[dt][3] * il) << 32); }
}
constexpr int SWP_ROWS = 272, SWP_K = 0, SWP_V = SWP_ROWS * SW_S, SW_TBL = 98304;
constexpr int SWS_ROWS = 160, SWS_K = 0, SWS_V = 2 * SWS_ROWS * SW_S;
static_assert(SWP_V + SWP_ROWS * SW_S <= SW_TBL && SWS_V + 2 * SWS_ROWS * SW_S <= SW_TBL && SW_TBL + 8192 <= RING_BYTES, "swa LDS");
__device__ __forceinline__ void swa_table(Frame& F, const Args& A) {
    __syncthreads();
    for (int e = F.tid; e < AH * WIN; e += NTHR) { const int h = e >> 7, d = e & 127; ((LAS float*)(F.lds + SW_TBL))[e] = A.in[22][t5_bucket(d) * 16 + h] * LOG2E; }
    __syncthreads();
}
__device__ __forceinline__ void swa_prompt_unit(Frame& F, const Args& A, int b, int blk, int kvh, int half) {
    const int lane = F.lane, tid = F.tid, w = F.wave, g = lane >> 4, c16 = lane & 15; LAS unsigned char* L = F.lds;
    const bf16* PROJ = (const bf16*)(A.ws + WS_PROJ); bf16* MIX = (bf16*)(A.ws + WS_MIX);
    __syncthreads();
#pragma unroll
    for (int j = 0; j < 5; ++j) { const int id = tid + NTHR * j; if (id < SWP_ROWS * 8) { const int row = id >> 3, ch = id & 7, pos = 128 * (blk - 1) + row;
        v4u kv = (v4u){0u, 0u, 0u, 0u}, vv = kv;
        if (row < 256 && pos >= 0) { const bf16* src = PROJ + ((size_t)b * SEQ + pos) * NPROJ + kvh * 64 + 8 * ch; kv = *(const GAS v4u*)(src + C_KA); vv = *(const GAS v4u*)(src + C_VA); }
        *(LAS v4u*)(L + SWP_K + row * SW_S + ch * 16) = kv; *(LAS v4u*)(L + SWP_V + row * SW_S + ch * 16) = vv; } }
    __syncthreads();
    const int qt = w, t = 128 * blk + 16 * qt + c16; const size_t row = (size_t)b * SEQ + t;
#pragma unroll 1
    for (int hl = 0; hl < 4; ++hl) { const int head = kvh * 8 + half * 4 + hl;
        bf16x8 qf[2];
#pragma unroll
        for (int ds = 0; ds < 2; ++ds) qf[ds] = *(const GAS bf16x8*)(PROJ + row * NPROJ + C_QA + head * 64 + 32 * ds + 8 * g);
        swa_core(L + SWP_K + 16 * qt * SW_S, L + SWP_V + 16 * qt * SW_S, (LAS const float*)(L + SW_TBL) + head * 128, qf, 128 + c16, blk == 0 ? 128 - 16 * qt : 0, A.in[20][head] * LOG2E,
                 MIX + row * DM + 1024 + head * 64, lane); }
}
__device__ __forceinline__ void swa_sample_unit(Frame& F, const Args& A, int b) {
    const int lane = F.lane, tid = F.tid, w = F.wave, g = lane >> 4, c16 = lane & 15; LAS unsigned char* L = F.lds;
    const bf16* PROJ = (const bf16*)(A.ws + WS_PROJ); bf16* MIX = (bf16*)(A.ws + WS_MIX);
    __syncthreads();
    for (int id = tid; id < 2 * 2 * SWS_ROWS * 8; id += NTHR) { const int ch = id & 7, row = (id >> 3) % SWS_ROWS, kvh = ((id >> 3) / SWS_ROWS) & 1, isv = (id >> 3) / (2 * SWS_ROWS);
        v4u o = (v4u){0u, 0u, 0u, 0u};
        if (row < WIN) { const float* src = A.in[isv ? 8 : 7] + ((size_t)b * WIN + row) * 128 + kvh * 64 + 8 * ch; const f32x4 f0 = *(const GAS f32x4*)src, f1 = *(const GAS f32x4*)(src + 4);
            o.x = pk2(f0.x, f0.y); o.y = pk2(f0.z, f0.w); o.z = pk2(f1.x, f1.y); o.w = pk2(f1.z, f1.w); }
        else if (row < WIN + DECS) o = *(const GAS v4u*)(PROJ + ((size_t)TP + 4 * b + (row - WIN)) * NPROJ + (isv ? C_VA : C_KA) + kvh * 64 + 8 * ch);
        *(LAS v4u*)(L + (isv ? SWS_V : SWS_K) + (kvh * SWS_ROWS + row) * SW_S + ch * 16) = o; }
    __syncthreads();
    if (w < 4) { const int kvh = w >> 1, sl = 16 * (w & 1) + c16, head = kvh * 8 + (sl >> 2), tok = sl & 3; const size_t row = (size_t)TP + 4 * b + tok;
        bf16x8 qf[2];
#pragma unroll
        for (int ds = 0; ds < 2; ++ds) qf[ds] = *(const GAS bf16x8*)(PROJ + row * NPROJ + C_QA + head * 64 + 32 * ds + 8 * g);
        swa_core(L + SWS_K + kvh * SWS_ROWS * SW_S, L + SWS_V + kvh * SWS_ROWS * SW_S, (LAS const float*)(L + SW_TBL) + head * 128, qf, 128 + tok, 0, A.in[20][head] * LOG2E,
                 MIX + row * DM + 1024 + head * 64, lane); }
}
__device__ __forceinline__ void swa_phase(Frame& F, const Args& A) {
    swa_table(F, A);
    for (int u = F.vcu; u < 256; u += F.G) swa_prompt_unit(F, A, u >> 6, (u >> 2) & 15, (u >> 1) & 1, u & 1);
    for (int u = F.G - 1 - F.vcu; u < DECB; u += F.G) swa_sample_unit(F, A, u);
    __syncthreads();
}
constexpr int N_PHASES = 10;
#ifndef MK_ONE_LAUNCH
#define MK_ONE_LAUNCH 1
#endif
__global__ void __launch_bounds__(NTHR, 2) hymba_fwd(Args args) {
    extern __shared__ __attribute__((aligned(16))) unsigned char lds[];
    Frame F;
    F.lds = (LAS unsigned char*)lds; F.MISC = (volatile LAS unsigned*)(F.lds + MISC_OFF);
    F.tid = threadIdx.x; F.lane = F.tid & 63; F.wave = __builtin_amdgcn_readfirstlane(F.tid >> 6);
    F.G = gridDim.x; { const int bx = blockIdx.x; F.vcu = (F.G % 8 == 0) ? (bx % 8) * (F.G / 8) + bx / 8 : bx; }
    F.gw = F.vcu * NWAVES + F.wave; F.ngw = F.G * NWAVES;
    unsigned char* ws = args.ws; F.ctl = (gu32*)(ws + WS_CTL);
    for (int u = F.tid; u < (LDS_BYTES - LDSCTL_OFF) / 4; u += NTHR) ((LAS unsigned*)(F.lds + LDSCTL_OFF))[u] = 0u;
    __syncthreads();
    XcdBarrier bar; bar.bar = (unsigned*)(F.ctl + CW_BAR); bar.x = 0; bar.st = nullptr;
    const int lo = args.ph_lo, hi = args.ph_hi;
    if (hi - lo > 1) bar = xcd_barrier_post((unsigned*)(F.ctl + CW_BAR), F.MISC + 8);
#define IN(k) (lo <= (k) && (k) < hi)
#define SEAM(k) do { if (IN(k) && IN((k) + 1)) xcd_barrier(bar); } while (0)
    bf16* const H = (bf16*)(ws + WS_H); bf16* const PROJ = (bf16*)(ws + WS_PROJ); bf16* const MIX = (bf16*)(ws + WS_MIX);
    float* const RSS1 = (float*)(ws + WS_RSS1); float* const RSS2 = (float*)(ws + WS_RSS2);
    float* const OUT = args.out;

    if (IN(0)) { p0_prologue(F, args); SEAM(0); }
    if (IN(1)) {
        { pg8::Gemm g{H, (const bf16*)(ws + WS_WIN), TT, NPROJ, DM}; pg8::StaticOrder S; S.init(TT, NPROJ, F.G, (int)blockIdx.x);
          pg8::EpiBf16Plain E{PROJ, NPROJ};
          pg8::gemm_phase<pg8::EpiBf16Plain, pg8::StaticOrder, true, true>(F.lds, g, S, E); }
        { pg8::Gemm g{(const bf16*)(ws + WS_MN), (const bf16*)(ws + WS_WKV), BATCH * NMEM, 1024, DM}; pg8::StaticOrder S; S.init(BATCH * NMEM, 1024, F.G, (int)((blockIdx.x + F.G - 66 % F.G) % F.G));
          pg8::EpiF32Plain E{(float*)(ws + WS_MKV), 1024};
          pg8::gemm_phase<pg8::EpiF32Plain, pg8::StaticOrder, true, true>(F.lds, g, S, E); }
        SEAM(1);
    }
    if (IN(2)) { p2_prep(F, args); SEAM(2); }
    if (IN(3)) { mlstm_prompt_phase(F, args); swa_phase(F, args); naive_mlstm_sample(F, args); __syncthreads(); SEAM(3); }
    if (IN(4)) {
        mlstm_state_combine(F, args);
        pg8::Gemm g{MIX, (const bf16*)(ws + WS_WOUT), TT, DM, DM}; pg8::StaticOrder S; S.init(TT, DM, F.G, (int)blockIdx.x);
        pg8::EpiResid<true> E{args.in[0], args.in[1], TP, OUT, H, RSS1, DM};
        pg8::gemm_phase<pg8::EpiResid<true>, pg8::StaticOrder, true, true>(F.lds, g, S, E);
        SEAM(4);
    }
    if (IN(5)) {
        pg8::Gemm g{H, (const bf16*)(ws + WS_WQ), TT, XW, DM}; pg8::StaticOrder S; S.init(TT, XW, F.G, (int)blockIdx.x);
        pg8::EpiScaleBf16<0> E{(bf16*)(ws + WS_QX), XW, RSS1, 1.0f / DM, EPS};
        pg8::gemm_phase<pg8::EpiScaleBf16<0>, pg8::StaticOrder, true, true>(F.lds, g, S, E);
        SEAM(5);
    }
    if (IN(6)) { xattn_phase(F, args); SEAM(6); }
    if (IN(7)) {
        pg8::Gemm g{(const bf16*)(ws + WS_OX), (const bf16*)(ws + WS_WO), TT, DM, XW}; pg8::StaticOrder S; S.init(TT, DM, F.G, (int)blockIdx.x);
        pg8::EpiResid<true> E{OUT, OUT, TT, OUT, H, RSS2, DM};
        pg8::gemm_phase<pg8::EpiResid<true>, pg8::StaticOrder, true, true>(F.lds, g, S, E);
        SEAM(7);
    }
    if (IN(8)) {
        pg8::Gemm g{H, (const bf16*)(ws + WS_WUP), TT, DFF, DM}; pg8::StaticOrder S; S.init(TT, DFF, F.G, (int)blockIdx.x);
        pg8::EpiScaleBf16<1> E{(bf16*)(ws + WS_U2), DFF, RSS2, 1.0f / DM, EPS};
        pg8::gemm_phase<pg8::EpiScaleBf16<1>, pg8::StaticOrder, true, true>(F.lds, g, S, E);
        SEAM(8);
    }
    if (IN(9)) {
        pg8::Gemm g{(const bf16*)(ws + WS_U2), (const bf16*)(ws + WS_WDN), TT, DM, DFF}; pg8::StaticOrder S; S.init(TT, DM, F.G, (int)blockIdx.x);
        pg8::EpiResid<false> E{OUT, OUT, TT, OUT, nullptr, nullptr, DM};
        pg8::gemm_phase<pg8::EpiResid<false>, pg8::StaticOrder, true, true>(F.lds, g, S, E);
    }
#undef IN
#undef SEAM
}

extern "C" void kernel_launch(void* const* d_in, const int* in_sizes, int n_in, void* d_out, int out_size, void* d_ws, size_t ws_size, hipStream_t stream) {
    static int grid = 0;
    if (grid == 0) {
        if (n_in != 34 || (size_t)out_size != O_END || ws_size < WS_END) { fprintf(stderr, "kernel_launch: unexpected shapes: n_in %d out %d (want %zu) ws %zu (want %zu)\n", n_in, out_size, (size_t)O_END, ws_size, (size_t)WS_END); grid = -1; return; }
        int dev = 0, cus = 0;
        if (hipGetDevice(&dev) != hipSuccess || hipDeviceGetAttribute(&cus, hipDeviceAttributeMultiprocessorCount, dev) != hipSuccess) { grid = -1; return; }
        if (hipFuncSetAttribute((const void*)hymba_fwd, hipFuncAttributeMaxDynamicSharedMemorySize, LDS_BYTES) != hipSuccess) { fprintf(stderr, "kernel_launch: hipFuncSetAttribute failed\n"); grid = -1; return; }
        (void)hipGetLastError();
        grid = cus;
    }
    if (grid < 0) return;
    (void)hipMemsetAsync((char*)d_ws + WS_CTL, 0, CTL_ZERO_BYTES, stream);
    Args a{};
    for (int i = 0; i < 34; ++i) a.in[i] = (const float*)d_in[i];
    a.out = (float*)d_out; a.ws = (unsigned char*)d_ws;
#if MK_ONE_LAUNCH
    a.ph_lo = 0; a.ph_hi = N_PHASES;
    hipLaunchKernelGGL(hymba_fwd, dim3(grid), dim3(NTHR), LDS_BYTES, stream, a);
#else
    for (int p = 0; p < N_PHASES; ++p) { a.ph_lo = p; a.ph_hi = p + 1; hipLaunchKernelGGL(hymba_fwd, dim3(grid), dim3(NTHR), LDS_BYTES, stream, a); }
#endif
}
```
